# Optimizing an MI355X kernel written in HIP

```python
import math
import jax, jax.numpy as jnp
from jax import lax
import numpy as np

D_MODEL = 2048
BATCH = 4
SEQ = 2048
DEPTH = 1
DEC_BATCH = 128
DEC_SEQ = 1
PAST_LEN = 16384
PAGE_SIZE = 128

POOL_WINDOWS = (2, 4, 8, 16)
N_POOL_GROUPS = len(POOL_WINDOWS)
POOL_GROUP_DIM = D_MODEL // 8
POOL_DIM = N_POOL_GROUPS * POOL_GROUP_DIM
POOL_BUF = max(POOL_WINDOWS) - 1
GDN_HEAD_DIM = 128
GDN_HEADS = D_MODEL // GDN_HEAD_DIM
GDN_DIM = GDN_HEADS * GDN_HEAD_DIM
QKV_DIM = 3 * GDN_DIM
CONV_WIDTH = 4
CONV_BUF = CONV_WIDTH - 1
CHUNK = 64
D_FF = -(-8 * D_MODEL // (3 * 256)) * 256
PLE_DIM = 256
EPS = 1e-6
POOL_OFF = 0
QKV_OFF = POOL_OFF + POOL_DIM
Z_OFF = QKV_OFF + QKV_DIM
A_OFF = Z_OFF + GDN_DIM
B_OFF = A_OFF + GDN_HEADS
GP_OFF = B_OFF + GDN_HEADS
GG_OFF = GP_OFF + D_MODEL
IN_COLS = GG_OFF + D_MODEL

kernel_name = "pool_gdn_gated_hybrid_step"


def rmsnorm(x, g):
    xf = x.astype(jnp.float32)
    y = xf * lax.rsqrt(jnp.mean(xf * xf, axis=-1, keepdims=True) + EPS)
    return (y * g.astype(jnp.float32)).astype(x.dtype)


def l2norm(x):
    xf = x.astype(jnp.float32)
    return xf * lax.rsqrt(jnp.sum(xf * xf, axis=-1, keepdims=True) + EPS)


def pool_mixer(u, prefix, start_pos, w_grp, scale):
    Bx, T, _ = u.shape
    ext = jnp.concatenate([prefix.astype(u.dtype), u], axis=1)
    ef = ext.astype(jnp.float32)
    cs = jnp.concatenate([jnp.zeros_like(ef[:, :1]), jnp.cumsum(ef, axis=1)], axis=1)
    end = cs[:, POOL_BUF + 1:POOL_BUF + 1 + T]
    pos = start_pos + jnp.arange(T)
    means = []
    for gi, w in enumerate(POOL_WINDOWS):
        sl = slice(gi * POOL_GROUP_DIM, (gi + 1) * POOL_GROUP_DIM)
        start = cs[:, POOL_BUF + 1 - w:POOL_BUF + 1 - w + T, sl]
        cnt = jnp.minimum(pos + 1, w).astype(jnp.float32)[None, :, None]
        means.append((end[..., sl] - start) / cnt)
    d = jnp.concatenate(means, axis=-1) - u.astype(jnp.float32)
    d = d.reshape(Bx, T, N_POOL_GROUPS, POOL_GROUP_DIM)
    y = jnp.einsum("btgc,gcd->btgd", d, w_grp.astype(jnp.float32)).reshape(Bx, T, POOL_DIM)
    y = y * scale.astype(jnp.float32)
    return y.astype(u.dtype), ext[:, -POOL_BUF:]


def short_conv(u, prefix, w):
    T = u.shape[1]
    ext = jnp.concatenate([prefix.astype(u.dtype), u], axis=1)
    y = ext[:, 0:T] * w[0]
    for i in range(1, CONV_WIDTH):
        y = y + ext[:, i:i + T] * w[i]
    return jax.nn.silu(y), ext[:, -CONV_BUF:]


def gated_delta_chunked(q, k, v, g, beta, s0):
    f32 = jnp.float32
    Bx, T, H, DK = q.shape
    DV = v.shape[-1]
    C = min(CHUNK, T)
    n = -(-T // C)
    pad = n * C - T

    def prep(a):
        a = jnp.pad(a.astype(f32), [(0, 0), (0, pad)] + [(0, 0)] * (a.ndim - 2))
        a = a.reshape((Bx, n, C) + a.shape[2:])
        return jnp.moveaxis(a, 3, 1)

    q, k, v, g, beta = prep(q), prep(k), prep(v), prep(g), prep(beta)
    gc = jnp.cumsum(g, axis=-1)
    causal = jnp.tril(jnp.ones((C, C), bool))
    strict = jnp.tril(jnp.ones((C, C), bool), -1)
    decay = jnp.exp(jnp.where(causal, gc[..., :, None] - gc[..., None, :], -jnp.inf))
    kb = k * beta[..., None]
    a_mat = jnp.where(strict, jnp.einsum("bhncd,bhnsd->bhncs", kb, k) * decay, 0.0)
    eg = jnp.exp(gc)
    rhs = jnp.concatenate([v * beta[..., None], kb * eg[..., None]], axis=-1)
    sol = lax.linalg.triangular_solve(a_mat + jnp.eye(C, dtype=f32), rhs,
                                      left_side=True, lower=True, unit_diagonal=True)
    u_val, w_dec = sol[..., :DV], sol[..., DV:]
    qk = jnp.where(causal, jnp.einsum("bhncd,bhnsd->bhncs", q, k) * decay, 0.0)
    q_dec = q * eg[..., None]
    k_tail = k * jnp.exp(gc[..., -1:] - gc)[..., None]
    g_last = jnp.exp(gc[..., -1])
    xs = tuple(jnp.moveaxis(a, 2, 0) for a in (u_val, w_dec, qk, q_dec, k_tail, g_last))

    def step(S, inp):
        u_c, w_c, qk_c, qd_c, kt_c, gl_c = inp
        v_new = u_c - jnp.einsum("bhcd,bhde->bhce", w_c, S)
        o = jnp.einsum("bhcd,bhde->bhce", qd_c, S) + jnp.einsum("bhcs,bhse->bhce", qk_c, v_new)
        S = S * gl_c[..., None, None] + jnp.einsum("bhcd,bhce->bhde", kt_c, v_new)
        return S, o

    S, o = lax.scan(step, s0.astype(f32), xs)
    o = jnp.moveaxis(o, 0, 2).reshape(Bx, H, n * C, DV)[:, :, :T]
    return jnp.transpose(o, (0, 2, 1, 3)), S


def _layer(x, p_l, pool_buf, conv_buf, ssm, start_pos,
           norm_mix, w_in, pool_w, pool_scale, conv_w, a_log, dt_bias, gdn_norm,
           w_pool_up, w_gdn_up, w_o, norm_ffn, w_gate_up, w_down, w_ple, w_ple_gate):
    f32 = jnp.float32
    Bx, T, _ = x.shape
    h = rmsnorm(x, norm_mix)
    proj = h @ w_in
    gate_pool = jax.nn.sigmoid(proj[..., GP_OFF:GP_OFF + D_MODEL])
    gate_gdn = jax.nn.sigmoid(proj[..., GG_OFF:GG_OFF + D_MODEL])
    pool_out, pool_new = pool_mixer(proj[..., POOL_OFF:POOL_OFF + POOL_DIM], pool_buf,
                                    start_pos, pool_w, pool_scale)
    qkv, conv_new = short_conv(proj[..., QKV_OFF:QKV_OFF + QKV_DIM], conv_buf, conv_w)
    qkv = qkv.reshape(Bx, T, 3, GDN_HEADS, GDN_HEAD_DIM)
    q = l2norm(qkv[:, :, 0]) * (GDN_HEAD_DIM ** -0.5)
    k = l2norm(qkv[:, :, 1])
    v = qkv[:, :, 2]
    beta = jax.nn.sigmoid(proj[..., B_OFF:B_OFF + GDN_HEADS].astype(f32))
    g = -jnp.exp(a_log.astype(f32)) * jax.nn.softplus(
        proj[..., A_OFF:A_OFF + GDN_HEADS].astype(f32) + dt_bias.astype(f32))
    o, ssm_new = gated_delta_chunked(q, k, v, g, beta, ssm)
    z = proj[..., Z_OFF:Z_OFF + GDN_DIM].reshape(Bx, T, GDN_HEADS, GDN_HEAD_DIM).astype(f32)
    o = rmsnorm(o, gdn_norm) * jax.nn.silu(z)
    gdn_out = o.reshape(Bx, T, GDN_DIM).astype(x.dtype)
    merged = gate_pool * (pool_out @ w_pool_up) + gate_gdn * (gdn_out @ w_gdn_up)
    x = x + merged @ w_o
    gu = rmsnorm(x, norm_ffn) @ w_gate_up
    x = x + (jax.nn.silu(gu[..., :D_FF]) * gu[..., D_FF:]) @ w_down
    x = x + (p_l @ w_ple) * jax.nn.sigmoid(x @ w_ple_gate)
    return x, pool_new, conv_new, ssm_new.astype(x.dtype)


def _trunk(x, p, pool_st, conv_st, ssm_st, start_pos, layer_w, norm_final):
    pools, convs, ssms = [], [], []
    for i in range(DEPTH):
        x, pb, cb, sb = _layer(x, p[i], pool_st[i], conv_st[i], ssm_st[i], start_pos,
                               *[w[i] for w in layer_w])
        pools.append(pb)
        convs.append(cb)
        ssms.append(sb)
    return rmsnorm(x, norm_final), jnp.stack(pools), jnp.stack(convs), jnp.stack(ssms)


def setup_inputs(seed: int = 0) -> dict:
    key = jax.random.key(seed)
    ks = jax.random.split(key, 24)
    nrm = lambda k, s, sc: jax.random.normal(k, s, jnp.float32) * sc
    L = DEPTH
    u = jax.random.uniform(ks[10], (L, GDN_HEADS), jnp.float32)
    dt = jnp.exp(u * (math.log(0.1) - math.log(1e-3)) + math.log(1e-3))
    return {
        "x_prompt": nrm(ks[0], (BATCH, SEQ, D_MODEL), 1.0),
        "x_sample": nrm(ks[1], (DEC_BATCH, DEC_SEQ, D_MODEL), 1.0),
        "p_prompt": nrm(ks[2], (L, BATCH, SEQ, PLE_DIM), 1.0),
        "p_sample": nrm(ks[3], (L, DEC_BATCH, DEC_SEQ, PLE_DIM), 1.0),
        "state_pool": nrm(ks[4], (L, DEC_BATCH, POOL_BUF, POOL_DIM), 1.0),
        "state_conv": nrm(ks[5], (L, DEC_BATCH, CONV_BUF, QKV_DIM), 1.0),
        "state_ssm": nrm(ks[6], (L, DEC_BATCH, GDN_HEADS, GDN_HEAD_DIM, GDN_HEAD_DIM), 0.1),
        "norm_mix": 1.0 + nrm(ks[7], (L, D_MODEL), 0.02),
        "w_in": nrm(ks[8], (L, D_MODEL, IN_COLS), D_MODEL ** -0.5),
        "pool_w": nrm(ks[9], (L, N_POOL_GROUPS, POOL_GROUP_DIM, POOL_GROUP_DIM), POOL_GROUP_DIM ** -0.5),
        "pool_scale": 1.0 + nrm(ks[11], (L, POOL_DIM), 0.02),
        "conv_w": nrm(ks[12], (L, CONV_WIDTH, QKV_DIM), CONV_WIDTH ** -0.5),
        "a_log": jnp.log(jax.random.uniform(ks[13], (L, GDN_HEADS), jnp.float32, 1.0, 16.0)),
        "dt_bias": dt + jnp.log(-jnp.expm1(-dt)),
        "gdn_norm": 1.0 + nrm(ks[14], (L, GDN_HEAD_DIM), 0.02),
        "w_pool_up": nrm(ks[15], (L, POOL_DIM, D_MODEL), POOL_DIM ** -0.5),
        "w_gdn_up": nrm(ks[16], (L, GDN_DIM, D_MODEL), GDN_DIM ** -0.5),
        "w_o": nrm(ks[17], (L, D_MODEL, D_MODEL), D_MODEL ** -0.5),
        "norm_ffn": 1.0 + nrm(ks[18], (L, D_MODEL), 0.02),
        "w_gate_up": nrm(ks[19], (L, D_MODEL, 2 * D_FF), D_MODEL ** -0.5),
        "w_down": nrm(ks[20], (L, D_FF, D_MODEL), D_FF ** -0.5),
        "w_ple": nrm(ks[21], (L, PLE_DIM, D_MODEL), PLE_DIM ** -0.5),
        "w_ple_gate": nrm(ks[22], (L, D_MODEL, D_MODEL), D_MODEL ** -0.5),
        "norm_final": 1.0 + nrm(ks[23], (D_MODEL,), 0.02),
    }


def reference(x_prompt, x_sample, p_prompt, p_sample, state_pool, state_conv, state_ssm,
              norm_mix, w_in, pool_w, pool_scale, conv_w, a_log, dt_bias, gdn_norm,
              w_pool_up, w_gdn_up, w_o, norm_ffn, w_gate_up, w_down, w_ple, w_ple_gate,
              norm_final):
    layer_w = (norm_mix, w_in, pool_w, pool_scale, conv_w, a_log, dt_bias, gdn_norm,
               w_pool_up, w_gdn_up, w_o, norm_ffn, w_gate_up, w_down, w_ple, w_ple_gate)
    dt_ = x_prompt.dtype
    zero_pool = jnp.zeros((DEPTH, BATCH, POOL_BUF, POOL_DIM), dt_)
    zero_conv = jnp.zeros((DEPTH, BATCH, CONV_BUF, QKV_DIM), dt_)
    zero_ssm = jnp.zeros((DEPTH, BATCH, GDN_HEADS, GDN_HEAD_DIM, GDN_HEAD_DIM), dt_)
    y_prompt, pool_p, conv_p, ssm_p = _trunk(x_prompt, p_prompt, zero_pool, zero_conv, zero_ssm,
                                             0, layer_w, norm_final)
    y_sample, pool_s, conv_s, ssm_s = _trunk(x_sample, p_sample, state_pool, state_conv, state_ssm,
                                             PAST_LEN, layer_w, norm_final)
    return (y_prompt, y_sample, pool_p, conv_p, ssm_p, pool_s, conv_s, ssm_s)
```

```cpp
#include <hip/hip_runtime.h>
#include <hip/hip_cooperative_groups.h>
#include <cstdio>
namespace cg = cooperative_groups;

#define LAS __attribute__((address_space(3)))
typedef unsigned short bf16_t;
typedef short bf16x8 __attribute__((ext_vector_type(8)));
typedef short bf16x4 __attribute__((ext_vector_type(4)));
typedef float f32x4 __attribute__((ext_vector_type(4)));
typedef unsigned u32x4 __attribute__((ext_vector_type(4)));
typedef unsigned u32x2 __attribute__((ext_vector_type(2)));

constexpr int DM = 2048, MP = 8192, MS = 128, MR = 8320, MT = 8448, SEQ = 2048;
constexpr int NQ = 9216;
constexpr int NG = 4096;
constexpr int NWIN = 13568;
constexpr int DFF = 5632;
constexpr int IN_COLS = 13344;
constexpr float EPS = 1e-6f;

constexpr int SWD = 132, SKT = 68;
constexpr int IMG_WD = 0, IMG_QD = 8448, IMG_KT = 16896, IMG_QK = 25600, IMG_ELEMS = 30208, IMG_BYTES = 60416, IMG_PIECES = 59;

constexpr size_t SZ_WPOOL = 4ull * 256 * 256 * 2, SZ_WPU = 2048ull * 1024 * 2, SZ_W2K = 2048ull * 2048 * 2;
constexpr size_t SZ_WGATE = 11264ull * 2048 * 2, SZ_WDOWN = 2048ull * 5632 * 2, SZ_WPLE = 2048ull * 256 * 2;
constexpr size_t SZ_ACT2K = (size_t)MT * 2048 * 2, SZ_F2K = (size_t)MT * 2048 * 4;
constexpr size_t WS_WPOOL = 0;
constexpr size_t WS_WPU = WS_WPOOL + SZ_WPOOL;
constexpr size_t WS_WGU = WS_WPU + SZ_WPU;
constexpr size_t WS_WO = WS_WGU + SZ_W2K;
constexpr size_t WS_WGATE = WS_WO + SZ_W2K;
constexpr size_t WS_WDOWN = WS_WGATE + SZ_WGATE;
constexpr size_t WS_WPLE = WS_WDOWN + SZ_WDOWN;
constexpr size_t WS_WPLEG = WS_WPLE + SZ_WPLE;
constexpr size_t WS_PBF = WS_WPLEG + SZ_W2K;
constexpr size_t WS_GB = WS_PBF + (size_t)MT * 256 * 2;
constexpr size_t WS_GL = WS_GB + (size_t)MT * 32 * 4;
constexpr size_t WS_B = WS_GL + 8192;
constexpr size_t SZ_B = (size_t)MT * 1024 * 2 * 2 + SZ_ACT2K;
constexpr size_t WS_WIN = WS_B;
constexpr size_t WS_D = WS_B, WS_POOLOUT = WS_D + (size_t)MT * 1024 * 2, WS_GDNOUT = WS_POOLOUT + (size_t)MT * 1024 * 2;
constexpr size_t WS_X2B = WS_GDNOUT;
constexpr size_t WS_PROJ = WS_B + SZ_B;
constexpr size_t SZ_PROJ = (size_t)MT * NQ * 2;
constexpr size_t WS_T1 = WS_PROJ, WS_MERGED = WS_T1 + SZ_F2K, WS_ACT = WS_PROJ;
constexpr size_t WS_GATES = WS_PROJ + SZ_PROJ;
constexpr size_t SZ_GATES = (size_t)MT * NG * 2;
constexpr size_t WS_T2 = WS_GATES;
constexpr size_t WS_CHUNK = WS_GATES + SZ_GATES;
constexpr size_t SZ_CHUNK = 2048ull * IMG_BYTES;
constexpr size_t WS_H = WS_CHUNK, WS_X1 = WS_CHUNK, WS_H2 = WS_X1 + SZ_F2K;
constexpr size_t WS_BAR = WS_CHUNK + SZ_CHUNK;
constexpr size_t WS_END = WS_BAR + 16384;
static_assert(SZ_F2K + SZ_ACT2K <= SZ_CHUNK, "X1+H2 fit");
static_assert(SZ_F2K + SZ_ACT2K <= SZ_PROJ && (size_t)MT * DFF * 2 <= SZ_PROJ, "T1+MERGED / ACT fit");
static_assert((size_t)NWIN * 2048 * 2 <= SZ_B, "WIN fits");

constexpr size_t O_YP = 0, O_YS = 16777216, O_POOLP = O_YS + 262144, O_CONVP = O_POOLP + 61440, O_SSMP = O_CONVP + 73728;
constexpr size_t O_POOLS = O_SSMP + 1048576, O_CONVS = O_POOLS + 1966080, O_SSMS = O_CONVS + 2359296;

constexpr int LDS_BYTES = 147456;

struct Params {
    const float* in[24];
    float* out;
    unsigned char* ws;
    int ph_lo, ph_hi;
};

typedef __bf16 bf16x2_t __attribute__((ext_vector_type(2)));
typedef float f32x2_t __attribute__((ext_vector_type(2)));
__device__ __forceinline__ unsigned pk2(float lo, float hi) { const f32x2_t v = {lo, hi}; const bf16x2_t b = __builtin_convertvector(v, bf16x2_t); return __builtin_bit_cast(unsigned, b); }
__device__ __forceinline__ bf16_t f2bf(float x) { return (bf16_t)(pk2(x, 0.f) & 0xffffu); }
__device__ __forceinline__ float bf2f(bf16_t b) { return __uint_as_float(((unsigned)b) << 16); }
__device__ __forceinline__ float bflo(unsigned w) { return __uint_as_float(w << 16); }
__device__ __forceinline__ float bfhi(unsigned w) { return __uint_as_float(w & 0xffff0000u); }
__device__ __forceinline__ float sigmoidf_(float x) { return __builtin_amdgcn_rcpf(1.0f + __expf(-x)); }
__device__ __forceinline__ float siluf_(float x) { return x * __builtin_amdgcn_rcpf(1.0f + __expf(-x)); }
__device__ __forceinline__ float wave_sum(float v) {
#pragma unroll
    for (int o = 1; o < 64; o <<= 1) v += __shfl_xor(v, o);
    return v;
}
__device__ __forceinline__ float bperm(float v, int srclane) { return __builtin_bit_cast(float, __builtin_amdgcn_ds_bpermute(srclane << 2, __builtin_bit_cast(int, v))); }
#define BAR_LDS() do { asm volatile("s_waitcnt lgkmcnt(0)" ::: "memory"); __builtin_amdgcn_s_barrier(); asm volatile("" ::: "memory"); } while (0)
__device__ __forceinline__ float dpp_sum16(float v) {
    v += __builtin_bit_cast(float, __builtin_amdgcn_update_dpp(0, __builtin_bit_cast(int, v), 0xB1, 0xF, 0xF, true));
    v += __builtin_bit_cast(float, __builtin_amdgcn_update_dpp(0, __builtin_bit_cast(int, v), 0x4E, 0xF, 0xF, true));
    v += __builtin_bit_cast(float, __builtin_amdgcn_update_dpp(0, __builtin_bit_cast(int, v), 0x141, 0xF, 0xF, true));
    v += __builtin_bit_cast(float, __builtin_amdgcn_update_dpp(0, __builtin_bit_cast(int, v), 0x140, 0xF, 0xF, true));
    return v;
}
#define LDS_WAIT() asm volatile("s_waitcnt lgkmcnt(0)" ::: "memory")
__device__ __forceinline__ int opaque_tid(int wave_s) { unsigned z; asm volatile("s_mov_b32 %0, 0" : "=s"(z));
    const int l = __builtin_amdgcn_mbcnt_hi(~0u, __builtin_amdgcn_mbcnt_lo(~0u, z)); int t = (wave_s << 6) | l; asm volatile("" : "+v"(t)); return t; }

namespace pg8 {
constexpr int BM = 256, BK = 64, HALF = 128, HTB = HALF * BK * 2, NXCD = 8, WGM = 8;
__device__ __forceinline__ int lds_byte(int r, int c) { const int st = (r >> 4) * 2 + (c >> 5), rr = r & 15, cc = c & 31, ob = rr * 64 + cc * 2; return st * 1024 + (ob ^ (((ob >> 9) & 1) << 5)); }
__device__ __forceinline__ void stage_rc(int b, int& R, int& C) { const int st = b / 1024, sb = b % 1024, swz = sb ^ (((sb >> 9) & 1) << 5); R = (st >> 1) * 16 + swz / 64; C = (st & 1) * 32 + (swz % 64) / 2; }
__device__ __forceinline__ int perm32(int rho) { const int n = rho >> 4, i = rho & 15; return 8 * (i >> 2) + 4 * n + (i & 3); }

struct Unit { int pm, pn; };
struct Gemm { const bf16_t* A; const bf16_t* Bt; int lda, ldb, K, nM, nN; long a_pn_off; };

struct StaticOrder {
    int nM, nN, nwg, G, c;
    __device__ void init(int nM_, int nN_, int G_, int c_) { nM = nM_; nN = nN_; nwg = nM * nN; G = G_; c = c_; }
    __device__ bool next(int i, Unit& u) const {
        const long L = (long)i * G + c; if (L >= nwg) return false;
        int wgid = (int)L; { const int q = nwg / NXCD, r = nwg % NXCD, xcd = wgid % NXCD, off = wgid / NXCD; wgid = (xcd < r ? xcd * (q + 1) : r * (q + 1) + (xcd - r) * q) + off; }
        const int nig = WGM * nN, gid = wgid / nig, fm = gid * WGM, gsz = (nM - fm) < WGM ? (nM - fm) : WGM;
        u.pm = fm + ((wgid % nig) % gsz); u.pn = (wgid % nig) / gsz; return true;
    }
};

template <class Epi>
__device__ __forceinline__ void gemm_phase(LAS unsigned char* lds, const Gemm g, const StaticOrder& S, const Epi& E, int wave_s) {
    const int tid = opaque_tid(wave_s), wid = __builtin_amdgcn_readfirstlane(tid >> 6), lane = tid & 63, wr = wid >> 2, wc = wid & 3, fr = lane & 15, fq = lane >> 4;
    const int K = g.K, nt = K / BK;
    unsigned voffA[2], voffB[2];
#pragma unroll
    for (int i = 0; i < 2; ++i) { int R, C; stage_rc(tid * 16 + i * 8192, R, C); const int Rb = (R & ~31) + perm32(R & 31);
        voffA[i] = (unsigned)(R * g.lda + C) * 2u; voffB[i] = (unsigned)(Rb * g.ldb + C) * 2u; }
    const size_t kstep = (size_t)(BK * 2);
    const size_t hstepA = (size_t)HALF * g.lda * 2, hstepB = (size_t)HALF * g.ldb * 2;
    const size_t tstepA = 2 * hstepA, tstepB = 2 * hstepB;
    const unsigned ldsw = (unsigned)wid * 1024u;
    const int aoff = lds_byte(wr * 64 + fr, fq * 8), boff = lds_byte(wc * 32 + fr, fq * 8);
#define PG8_SA(b, h) (((b) * 2 + (h)) * HTB)
#define PG8_SB(b, h) ((4 + (b) * 2 + (h)) * HTB)
#define PG8_STAGE(bufoff, gbase, voff) do { _Pragma("unroll") for (int _i = 0; _i < 2; ++_i) \
        __builtin_amdgcn_global_load_lds((const unsigned*)((const char*)(gbase) + (voff)[_i]), (LAS unsigned*)(lds + (bufoff) + ldsw + _i * 8192), 16, 0, 0); } while (0)
#define PG8_LDA(dst, b, h) do { _Pragma("unroll") for (int m = 0; m < 4; ++m) _Pragma("unroll") for (int k = 0; k < 2; ++k) dst[m][k] = *(const LAS bf16x8*)(lds + PG8_SA(b, h) + aoff + m * 2048 + k * 1024); } while (0)
#define PG8_LDB(dst, b, h) do { _Pragma("unroll") for (int n = 0; n < 2; ++n) _Pragma("unroll") for (int k = 0; k < 2; ++k) dst[n][k] = *(const LAS bf16x8*)(lds + PG8_SB(b, h) + boff + n * 2048 + k * 1024); } while (0)
#define PG8_MMA(ai, bj, At, Bt) do { __builtin_amdgcn_s_setprio(1); _Pragma("unroll") for (int m = 0; m < 4; ++m) _Pragma("unroll") for (int n = 0; n < 2; ++n) _Pragma("unroll") for (int k = 0; k < 2; ++k) \
        acc[ai][bj][m][n] = __builtin_amdgcn_mfma_f32_16x16x32_bf16(Bt[n][k], At[m][k], acc[ai][bj][m][n], 0, 0, 0); __builtin_amdgcn_s_setprio(0); } while (0)
#define PG8_WAIT_V(n) asm volatile("s_waitcnt vmcnt(" #n ")" ::: "memory")
#define PG8_WAIT_L(n) asm volatile("s_waitcnt lgkmcnt(" #n ")" ::: "memory")
#define PG8_BAR __builtin_amdgcn_s_barrier()
#define PG8_SCHED __builtin_amdgcn_sched_barrier(0)
    Unit cur, nxt; int ui = 0;
    if (!S.next(0, cur)) return;
    f32x4 acc[2][2][4][2];
#pragma unroll
    for (int a = 0; a < 2; ++a)
#pragma unroll
        for (int b = 0; b < 2; ++b)
#pragma unroll
            for (int m = 0; m < 4; ++m)
#pragma unroll
                for (int n = 0; n < 2; ++n) acc[a][b][m][n] = (f32x4){0.f, 0.f, 0.f, 0.f};
    bf16x8 At[4][2], B0[2][2], B1[2][2];
    const char* cA = (const char*)g.A + (size_t)cur.pm * tstepA + (size_t)cur.pn * g.a_pn_off * 2; const char* cB = (const char*)g.Bt + (size_t)cur.pn * tstepB;
    PG8_STAGE(PG8_SB(0, 0), cB, voffB); PG8_STAGE(PG8_SB(0, 1), cB + hstepB, voffB); PG8_STAGE(PG8_SA(0, 0), cA, voffA); PG8_STAGE(PG8_SA(0, 1), cA + hstepA, voffA);
    if (wr == 1) PG8_BAR;
    PG8_WAIT_V(2); PG8_BAR;
    PG8_STAGE(PG8_SB(1, 0), cB + kstep, voffB); PG8_STAGE(PG8_SA(1, 0), cA + kstep, voffA); PG8_STAGE(PG8_SB(1, 1), cB + hstepB + kstep, voffB);
    PG8_WAIT_V(6); PG8_BAR;
    for (;;) {
        const bool has_next = S.next(ui + 1, nxt);
        const char* nA = has_next ? (const char*)g.A + (size_t)nxt.pm * tstepA + (size_t)nxt.pn * g.a_pn_off * 2 : cA; const char* nB = has_next ? (const char*)g.Bt + (size_t)nxt.pn * tstepB : cB;
        for (int t = 0; t < nt; t += 2) {
            const bool last = (t == nt - 2);
            const char* a1 = cA + (size_t)(t + 1) * kstep;
            const char* a2 = last ? nA : cA + (size_t)(t + 2) * kstep; const char* b2 = last ? nB : cB + (size_t)(t + 2) * kstep;
            const char* a3 = a2 + kstep; const char* b3 = b2 + kstep;
            PG8_LDB(B0, 0, 0); PG8_LDB(B1, 0, 1); PG8_SCHED; PG8_LDA(At, 0, 0); PG8_STAGE(PG8_SA(1, 1), a1 + hstepA, voffA);
            PG8_WAIT_V(8); PG8_WAIT_L(0); PG8_BAR; PG8_MMA(0, 0, At, B0); PG8_MMA(0, 1, At, B1); PG8_BAR; PG8_SCHED;
            PG8_LDA(At, 0, 1); PG8_STAGE(PG8_SB(0, 0), b2, voffB); PG8_STAGE(PG8_SB(0, 1), b2 + hstepB, voffB); PG8_STAGE(PG8_SA(0, 0), a2, voffA);
            PG8_WAIT_V(8); PG8_WAIT_L(0); PG8_BAR; PG8_MMA(1, 0, At, B0); PG8_MMA(1, 1, At, B1); PG8_BAR; PG8_SCHED;
            PG8_LDB(B0, 1, 0); PG8_LDB(B1, 1, 1); PG8_SCHED; PG8_LDA(At, 1, 0); PG8_STAGE(PG8_SA(0, 1), a2 + hstepA, voffA);
            PG8_WAIT_V(8); PG8_WAIT_L(0); PG8_BAR; PG8_MMA(0, 0, At, B0); PG8_MMA(0, 1, At, B1); PG8_BAR; PG8_SCHED;
            PG8_LDA(At, 1, 1); PG8_STAGE(PG8_SB(1, 0), b3, voffB); PG8_STAGE(PG8_SB(1, 1), b3 + hstepB, voffB); PG8_STAGE(PG8_SA(1, 0), a3, voffA);
            PG8_WAIT_V(8); PG8_WAIT_L(0); PG8_BAR; PG8_MMA(1, 0, At, B0); PG8_MMA(1, 1, At, B1); PG8_BAR; PG8_SCHED;
        }
        if (wr == 0) PG8_BAR;
        E(acc, cur, wr, wc, fr, fq);
        if (!has_next) break;
#pragma unroll
        for (int a = 0; a < 2; ++a)
#pragma unroll
            for (int b = 0; b < 2; ++b)
#pragma unroll
                for (int m = 0; m < 4; ++m)
#pragma unroll
                    for (int n = 0; n < 2; ++n) acc[a][b][m][n] = (f32x4){0.f, 0.f, 0.f, 0.f};
        cur = nxt; cA = nA; cB = nB; ++ui;
        if (wr == 1) PG8_BAR;
    }
    PG8_WAIT_V(0);
    PG8_BAR;
#undef PG8_SA
#undef PG8_SB
#undef PG8_STAGE
#undef PG8_LDA
#undef PG8_LDB
#undef PG8_MMA
#undef PG8_WAIT_V
#undef PG8_WAIT_L
#undef PG8_BAR
#undef PG8_SCHED
}
}
using pg8::Unit;

#define EPI_ARGS const f32x4 (&acc)[2][2][4][2], const Unit& u, int wr, int wc, int fr, int fq
#define EPI_ROW(ai, m) (u.pm * 256 + (ai) * 128 + wr * 64 + (m) * 16 + fr)
#define EPI_COL0 (u.pn * 256 + wc * 32 + fq * 8)
#define EPI_FENCE asm volatile("" ::: "memory")

__device__ __forceinline__ u32x4 pack8(f32x4 v0, f32x4 v1) { u32x4 w; w.x = pk2(v0[0], v0[1]); w.y = pk2(v0[2], v0[3]); w.z = pk2(v1[0], v1[1]); w.w = pk2(v1[2], v1[3]); return w; }

struct EpiProj {
    bf16_t* proj; bf16_t* gates; float* gb; const float* a_log; const float* dt_bias; float* out;
    __device__ __forceinline__ void operator()(EPI_ARGS) const {
        const int col0 = EPI_COL0;
        if (u.pn < 36) {
#pragma unroll
            for (int ai = 0; ai < 2; ++ai)
#pragma unroll
                for (int m = 0; m < 4; ++m) { const int r = EPI_ROW(ai, m); bf16_t* rowp = proj + (size_t)r * NQ + col0;
#pragma unroll
                    for (int bj = 0; bj < 2; ++bj) *(u32x4*)(rowp + bj * 128) = pack8(acc[ai][bj][m][0], acc[ai][bj][m][1]); }
            if (u.pn < 28) {
                const bool tailpm = ((u.pm & 7) == 7) && (u.pm < 32), samp = (u.pm == 32);
                if (tailpm || samp) {
#pragma unroll
                    for (int ai = 0; ai < 2; ++ai)
#pragma unroll
                        for (int m = 0; m < 4; ++m) { const int r = EPI_ROW(ai, m); float* dst = nullptr;
                            if (tailpm) { const int t = r & 2047, b = r >> 11;
                                if (u.pn < 4) { if (t >= 2033) dst = out + O_POOLP + ((size_t)(b * 15 + (t - 2033)) * 1024 + col0); }
                                else { if (t >= 2045) dst = out + O_CONVP + ((size_t)(b * 3 + (t - 2045)) * 6144 + (col0 - 1024)); } }
                            else { const int s = r - MP; if (s < MS) { if (u.pn < 4) dst = out + O_POOLS + ((size_t)(s * 15 + 14) * 1024 + col0); else dst = out + O_CONVS + ((size_t)(s * 3 + 2) * 6144 + (col0 - 1024)); } }
                            if (dst) {
#pragma unroll
                                for (int bj = 0; bj < 2; ++bj) { *(f32x4*)(dst + bj * 128) = acc[ai][bj][m][0]; *(f32x4*)(dst + bj * 128 + 4) = acc[ai][bj][m][1]; } } }
                }
            }
        } else if (u.pn < 52) {
            const int gc0 = col0 - 36 * 256;
#pragma unroll
            for (int ai = 0; ai < 2; ++ai)
#pragma unroll
                for (int m = 0; m < 4; ++m) { const int r = EPI_ROW(ai, m); bf16_t* rowp = gates + (size_t)r * NG + gc0;
#pragma unroll
                    for (int bj = 0; bj < 2; ++bj) { f32x4 v0 = acc[ai][bj][m][0], v1 = acc[ai][bj][m][1];
#pragma unroll
                        for (int j = 0; j < 4; ++j) { v0[j] = sigmoidf_(v0[j]); v1[j] = sigmoidf_(v1[j]); }
                        *(u32x4*)(rowp + bj * 128) = pack8(v0, v1); } }
        } else {
            if (wc == 0) {
                const int c0 = fq * 8;
                float al[8], db[8];
#pragma unroll
                for (int j = 0; j < 8; ++j) { const int h = (c0 + j) & 15; al[j] = -__expf(a_log[h]); db[j] = dt_bias[h]; }
#pragma unroll
                for (int ai = 0; ai < 2; ++ai)
#pragma unroll
                    for (int m = 0; m < 4; ++m) { const int r = EPI_ROW(ai, m); float v[8];
#pragma unroll
                        for (int j = 0; j < 4; ++j) { v[j] = acc[ai][0][m][0][j]; v[4 + j] = acc[ai][0][m][1][j]; }
#pragma unroll
                        for (int j = 0; j < 8; ++j) {
                            if (fq < 2) { const float x = v[j] + db[j]; const float sp = (x > 20.f) ? x : log1pf(__expf(x)); v[j] = al[j] * sp; }
                            else v[j] = sigmoidf_(v[j]); }
                        float* dst = gb + (size_t)r * 32 + c0;
                        *(f32x4*)dst = (f32x4){v[0], v[1], v[2], v[3]}; *(f32x4*)(dst + 4) = (f32x4){v[4], v[5], v[6], v[7]}; }
            }
        }
    }
};
struct EpiPoolGrp {
    bf16_t* o; const float* scale;
    __device__ __forceinline__ void operator()(EPI_ARGS) const {
        const int col0 = EPI_COL0;
#pragma unroll
        for (int ai = 0; ai < 2; ++ai)
#pragma unroll
            for (int m = 0; m < 4; ++m) { const int r = EPI_ROW(ai, m); bf16_t* rowp = o + (size_t)r * 1024 + col0;
#pragma unroll
                for (int bj = 0; bj < 2; ++bj) { const f32x4 sc0 = *(const f32x4*)(scale + col0 + bj * 128), sc1 = *(const f32x4*)(scale + col0 + bj * 128 + 4);
                    *(u32x4*)(rowp + bj * 128) = pack8(acc[ai][bj][m][0] * sc0, acc[ai][bj][m][1] * sc1); }
                EPI_FENCE; }
    }
};
struct EpiPoolUp {
    bf16_t* t1; const bf16_t* gates;
    __device__ __forceinline__ void operator()(EPI_ARGS) const {
        const int col0 = EPI_COL0;
#pragma unroll
        for (int ai = 0; ai < 2; ++ai)
#pragma unroll
            for (int m = 0; m < 4; ++m) { const int r = EPI_ROW(ai, m); bf16_t* rowp = t1 + (size_t)r * DM + col0; const bf16_t* gp = gates + (size_t)r * NG + col0;
#pragma unroll
                for (int bj = 0; bj < 2; ++bj) { const u32x4 gw = __builtin_nontemporal_load((const u32x4*)(gp + bj * 128));
                    f32x4 g0 = (f32x4){bflo(gw.x), bfhi(gw.x), bflo(gw.y), bfhi(gw.y)}, g1 = (f32x4){bflo(gw.z), bfhi(gw.z), bflo(gw.w), bfhi(gw.w)};
                    *(u32x4*)(rowp + bj * 128) = pack8(acc[ai][bj][m][0] * g0, acc[ai][bj][m][1] * g1); }
                if (m == 3) EPI_FENCE; }
    }
};
struct EpiMerge {
    const bf16_t* t1; const bf16_t* gates; bf16_t* merged;
    __device__ __forceinline__ void operator()(EPI_ARGS) const {
        const int col0 = EPI_COL0;
#pragma unroll
        for (int ai = 0; ai < 2; ++ai)
#pragma unroll
            for (int m = 0; m < 4; ++m) { const int r = EPI_ROW(ai, m); const bf16_t* tp = t1 + (size_t)r * DM + col0; const bf16_t* gp = gates + (size_t)r * NG + 2048 + col0; bf16_t* op = merged + (size_t)r * DM + col0;
#pragma unroll
                for (int bj = 0; bj < 2; ++bj) { const u32x4 gw = __builtin_nontemporal_load((const u32x4*)(gp + bj * 128)), tw = __builtin_nontemporal_load((const u32x4*)(tp + bj * 128));
                    f32x4 g0 = (f32x4){bflo(gw.x), bfhi(gw.x), bflo(gw.y), bfhi(gw.y)}, g1 = (f32x4){bflo(gw.z), bfhi(gw.z), bflo(gw.w), bfhi(gw.w)};
                    const f32x4 a0 = (f32x4){bflo(tw.x), bfhi(tw.x), bflo(tw.y), bfhi(tw.y)}, a1 = (f32x4){bflo(tw.z), bfhi(tw.z), bflo(tw.w), bfhi(tw.w)};
                    *(u32x4*)(op + bj * 128) = pack8(a0 + acc[ai][bj][m][0] * g0, a1 + acc[ai][bj][m][1] * g1); }
                if (m == 3) EPI_FENCE; }
    }
};
struct EpiWo {
    const float* xp; const float* xs; bf16_t* x1b;
    __device__ __forceinline__ void operator()(EPI_ARGS) const {
        const int col0 = EPI_COL0;
#pragma unroll
        for (int ai = 0; ai < 2; ++ai)
#pragma unroll
            for (int m = 0; m < 4; ++m) { const int r = EPI_ROW(ai, m); bf16_t* op = x1b + (size_t)r * DM + col0;
                const float* xr = (r < MP) ? xp + (size_t)r * DM + col0 : xs + (size_t)((r < MR ? r : MP) - MP) * DM + col0;
#pragma unroll
                for (int bj = 0; bj < 2; ++bj) { const f32x4 a0 = __builtin_nontemporal_load((const f32x4*)(xr + bj * 128)), a1 = __builtin_nontemporal_load((const f32x4*)(xr + bj * 128 + 4));
                    *(u32x4*)(op + bj * 128) = pack8(a0 + acc[ai][bj][m][0], a1 + acc[ai][bj][m][1]); }
                if (m == 3) EPI_FENCE; }
    }
};
struct EpiGateUp {
    bf16_t* act;
    __device__ __forceinline__ void operator()(EPI_ARGS) const {
        const int col0 = u.pn * 128 + wc * 32 + fq * 8;
#pragma unroll
        for (int ai = 0; ai < 2; ++ai)
#pragma unroll
            for (int m = 0; m < 4; ++m) { const int r = EPI_ROW(ai, m); f32x4 v0, v1;
#pragma unroll
                for (int j = 0; j < 4; ++j) { v0[j] = siluf_(acc[ai][0][m][0][j]) * acc[ai][1][m][0][j]; v1[j] = siluf_(acc[ai][0][m][1][j]) * acc[ai][1][m][1][j]; }
                *(u32x4*)(act + (size_t)r * DFF + col0) = pack8(v0, v1); }
    }
};
struct EpiDown {
    const bf16_t* x1b; bf16_t* x2b;
    __device__ __forceinline__ void operator()(EPI_ARGS) const {
        const int col0 = EPI_COL0;
#pragma unroll
        for (int ai = 0; ai < 2; ++ai)
#pragma unroll
            for (int m = 0; m < 4; ++m) { const int r = EPI_ROW(ai, m); const bf16_t* op = x1b + (size_t)r * DM + col0; bf16_t* bp = x2b + (size_t)r * DM + col0;
#pragma unroll
                for (int bj = 0; bj < 2; ++bj) { const u32x4 xw = __builtin_nontemporal_load((const u32x4*)(op + bj * 128));
                    const f32x4 a0 = (f32x4){bflo(xw.x), bfhi(xw.x), bflo(xw.y), bfhi(xw.y)}, a1 = (f32x4){bflo(xw.z), bfhi(xw.z), bflo(xw.w), bfhi(xw.w)};
                    *(u32x4*)(bp + bj * 128) = pack8(a0 + acc[ai][bj][m][0], a1 + acc[ai][bj][m][1]); }
                if (m == 3) EPI_FENCE; }
    }
};
struct EpiPle {
    bf16_t* t2;
    __device__ __forceinline__ void operator()(EPI_ARGS) const {
        const int col0 = EPI_COL0;
#pragma unroll
        for (int ai = 0; ai < 2; ++ai)
#pragma unroll
            for (int m = 0; m < 4; ++m) { const int r = EPI_ROW(ai, m); bf16_t* op = t2 + (size_t)r * DM + col0;
#pragma unroll
                for (int bj = 0; bj < 2; ++bj) *(u32x4*)(op + bj * 128) = pack8(acc[ai][bj][m][0], acc[ai][bj][m][1]);
                EPI_FENCE; }
    }
};
struct EpiPleGate {
    bf16_t* x3; const bf16_t* x2b; const bf16_t* t2;
    __device__ __forceinline__ void operator()(EPI_ARGS) const {
        const int col0 = EPI_COL0;
#pragma unroll
        for (int ai = 0; ai < 2; ++ai)
#pragma unroll
            for (int m = 0; m < 4; ++m) { const int r = EPI_ROW(ai, m); bf16_t* op = x3 + (size_t)r * DM + col0; const bf16_t* xp = x2b + (size_t)r * DM + col0; const bf16_t* tp = t2 + (size_t)r * DM + col0;
#pragma unroll
                for (int bj = 0; bj < 2; ++bj) { const u32x4 xw = *(const u32x4*)(xp + bj * 128), tw = __builtin_nontemporal_load((const u32x4*)(tp + bj * 128));
                    f32x4 a0 = (f32x4){bflo(xw.x), bfhi(xw.x), bflo(xw.y), bfhi(xw.y)}, a1 = (f32x4){bflo(xw.z), bfhi(xw.z), bflo(xw.w), bfhi(xw.w)};
                    const f32x4 p0 = (f32x4){bflo(tw.x), bfhi(tw.x), bflo(tw.y), bfhi(tw.y)}, p1 = (f32x4){bflo(tw.z), bfhi(tw.z), bflo(tw.w), bfhi(tw.w)};
#pragma unroll
                    for (int j = 0; j < 4; ++j) { a0[j] += p0[j] * sigmoidf_(acc[ai][bj][m][0][j]); a1[j] += p1[j] * sigmoidf_(acc[ai][bj][m][1][j]); }
                    *(u32x4*)(op + bj * 128) = pack8(a0, a1); }
                if (m == 3) EPI_FENCE; }
    }
};

__device__ __forceinline__ void transpose_item(const float* W, int N, int K, bf16_t* WT, int k0, int n0src, int n0dst, LAS float* scr, int lane) {
    float tv[32];
#pragma unroll
    for (int i = 0; i < 32; ++i) tv[i] = __builtin_nontemporal_load(&W[(size_t)(k0 + 2 * i + (lane >> 5)) * N + n0src + (lane & 31)]);
#pragma unroll
    for (int i = 0; i < 32; ++i) scr[(2 * i + (lane >> 5)) * 33 + (lane & 31)] = tv[i];
    LDS_WAIT();
    const int c = lane & 7;
#pragma unroll
    for (int j = 0; j < 4; ++j) { const int n = (lane >> 3) + 8 * j; const LAS float* s = scr + (8 * c) * 33 + n;
        u32x4 o; o.x = pk2(s[0 * 33], s[1 * 33]); o.y = pk2(s[2 * 33], s[3 * 33]); o.z = pk2(s[4 * 33], s[5 * 33]); o.w = pk2(s[6 * 33], s[7 * 33]);
        *(u32x4*)(WT + (size_t)(n0dst + n) * K + k0 + 8 * c) = o; }
    LDS_WAIT();
}
constexpr int CV_WIN = 32 * 417, CV_POOL = 4 * 4 * 8, CV_WPU = 16 * 64, CV_2K = 32 * 64, CV_GATE = 32 * 352, CV_DOWN = 88 * 64, CV_PLE = 4 * 64;
constexpr int CV_SPLIT = CV_WIN + CV_POOL + CV_WPU + 2 * CV_2K + CV_GATE, CV_END = CV_SPLIT + CV_2K + CV_DOWN + CV_PLE;
__device__ __forceinline__ void convert_items(const Params& p, LAS float* scr, int lane, int gw, int NGW, int it_lo, int it_hi) {
    unsigned char* ws = p.ws;
    for (int it = it_lo + gw; it < it_hi; it += NGW) {
        int r = it;
        if (r < CV_WIN) { const int kb = r / 417, nb = r % 417, ns = nb * 32; const int nd = ns < 9216 ? ns : (ns < 9248 ? 13312 + (ns - 9216) : ns - 32);
            transpose_item(p.in[8], IN_COLS, 2048, (bf16_t*)(ws + WS_WIN), kb * 64, ns, nd, scr, lane); continue; } r -= CV_WIN;
        if (r < CV_POOL) { const int g = r / 32, q = r % 32, kb = q / 8, nb = q % 8;
            transpose_item(p.in[9] + g * 65536, 256, 256, (bf16_t*)(ws + WS_WPOOL) + g * 65536, kb * 64, nb * 32, nb * 32, scr, lane); continue; } r -= CV_POOL;
        if (r < CV_WPU) { const int kb = r / 64, nb = r % 64; transpose_item(p.in[15], 2048, 1024, (bf16_t*)(ws + WS_WPU), kb * 64, nb * 32, nb * 32, scr, lane); continue; } r -= CV_WPU;
        if (r < CV_2K) { const int kb = r / 64, nb = r % 64; transpose_item(p.in[16], 2048, 2048, (bf16_t*)(ws + WS_WGU), kb * 64, nb * 32, nb * 32, scr, lane); continue; } r -= CV_2K;
        if (r < CV_2K) { const int kb = r / 64, nb = r % 64; transpose_item(p.in[17], 2048, 2048, (bf16_t*)(ws + WS_WO), kb * 64, nb * 32, nb * 32, scr, lane); continue; } r -= CV_2K;
        if (r < CV_GATE) { const int kb = r / 352, nb = r % 352, ns = nb * 32; int nd; if (ns < DFF) nd = 256 * (ns / 128) + (ns % 128); else { const int j = ns - DFF; nd = 256 * (j / 128) + 128 + (j % 128); }
            transpose_item(p.in[19], 2 * DFF, 2048, (bf16_t*)(ws + WS_WGATE), kb * 64, ns, nd, scr, lane); continue; } r -= CV_GATE;
        if (r < CV_2K) { const int kb = r / 64, nb = r % 64; transpose_item(p.in[22], 2048, 2048, (bf16_t*)(ws + WS_WPLEG), kb * 64, nb * 32, nb * 32, scr, lane); continue; } r -= CV_2K;
        if (r < CV_DOWN) { const int kb = r / 64, nb = r % 64; transpose_item(p.in[20], 2048, DFF, (bf16_t*)(ws + WS_WDOWN), kb * 64, nb * 32, nb * 32, scr, lane); continue; } r -= CV_DOWN;
        { const int kb = r / 64, nb = r % 64; transpose_item(p.in[21], 2048, 256, (bf16_t*)(ws + WS_WPLE), kb * 64, nb * 32, nb * 32, scr, lane); }
    }
}
__device__ __forceinline__ void rms_row_bf16(const float* xrow, const float* g, bf16_t* orow, int lane) {
    const f32x4* xr = (const f32x4*)xrow + lane; f32x4 v[8]; float s = 0.f;
#pragma unroll
    for (int j = 0; j < 8; ++j) { v[j] = __builtin_nontemporal_load(xr + 64 * j); s += (v[j].x * v[j].x + v[j].y * v[j].y) + (v[j].z * v[j].z + v[j].w * v[j].w); }
    const float rstd = rsqrtf(wave_sum(s) * (1.f / DM) + EPS);
    const f32x4* gr = (const f32x4*)g + lane; u32x2* o8 = (u32x2*)orow + lane;
#pragma unroll
    for (int j = 0; j < 8; ++j) { const f32x4 gg = gr[64 * j]; u32x2 w; w.x = pk2(v[j].x * rstd * gg.x, v[j].y * rstd * gg.y); w.y = pk2(v[j].z * rstd * gg.z, v[j].w * rstd * gg.w); o8[64 * j] = w; }
}
__device__ __forceinline__ void rms_row_b2b(const bf16_t* xrow, const float* g, bf16_t* orow, int lane) {
    const u32x4* xr = (const u32x4*)xrow + lane; u32x4 w[4]; float s = 0.f;
#pragma unroll
    for (int j = 0; j < 4; ++j) { w[j] = xr[64 * j];
        const float a0 = bflo(w[j].x), a1 = bfhi(w[j].x), a2 = bflo(w[j].y), a3 = bfhi(w[j].y), a4 = bflo(w[j].z), a5 = bfhi(w[j].z), a6 = bflo(w[j].w), a7 = bfhi(w[j].w);
        s += ((a0 * a0 + a1 * a1) + (a2 * a2 + a3 * a3)) + ((a4 * a4 + a5 * a5) + (a6 * a6 + a7 * a7)); }
    const float rstd = rsqrtf(wave_sum(s) * (1.f / DM) + EPS);
    u32x4* o = (u32x4*)orow + lane;
#pragma unroll
    for (int j = 0; j < 4; ++j) { const f32x4 g0 = ((const f32x4*)g)[(64 * j + lane) * 2], g1 = ((const f32x4*)g)[(64 * j + lane) * 2 + 1]; u32x4 r;
        r.x = pk2(bflo(w[j].x) * rstd * g0.x, bfhi(w[j].x) * rstd * g0.y); r.y = pk2(bflo(w[j].y) * rstd * g0.z, bfhi(w[j].y) * rstd * g0.w);
        r.z = pk2(bflo(w[j].z) * rstd * g1.x, bfhi(w[j].z) * rstd * g1.y); r.w = pk2(bflo(w[j].w) * rstd * g1.z, bfhi(w[j].w) * rstd * g1.w); o[64 * j] = r; }
}
__device__ __forceinline__ void rms_row_b2f(const bf16_t* xrow, const float* g, float* orow, int lane) {
    const u32x4* xr = (const u32x4*)xrow + lane; u32x4 w[4]; float s = 0.f;
#pragma unroll
    for (int j = 0; j < 4; ++j) { w[j] = xr[64 * j];
        const float a0 = bflo(w[j].x), a1 = bfhi(w[j].x), a2 = bflo(w[j].y), a3 = bfhi(w[j].y), a4 = bflo(w[j].z), a5 = bfhi(w[j].z), a6 = bflo(w[j].w), a7 = bfhi(w[j].w);
        s += ((a0 * a0 + a1 * a1) + (a2 * a2 + a3 * a3)) + ((a4 * a4 + a5 * a5) + (a6 * a6 + a7 * a7)); }
    const float rstd = rsqrtf(wave_sum(s) * (1.f / DM) + EPS);
    f32x4* o = (f32x4*)orow;
#pragma unroll
    for (int j = 0; j < 4; ++j) { const int q = (64 * j + lane) * 2; const f32x4 g0 = ((const f32x4*)g)[q], g1 = ((const f32x4*)g)[q + 1];
        __builtin_nontemporal_store((f32x4){bflo(w[j].x) * rstd * g0.x, bfhi(w[j].x) * rstd * g0.y, bflo(w[j].y) * rstd * g0.z, bfhi(w[j].y) * rstd * g0.w}, o + q);
        __builtin_nontemporal_store((f32x4){bflo(w[j].z) * rstd * g1.x, bfhi(w[j].z) * rstd * g1.y, bflo(w[j].w) * rstd * g1.z, bfhi(w[j].w) * rstd * g1.w}, o + q + 1); }
}
__device__ __forceinline__ void rms_row_f32(const float* xrow, const float* g, float* orow, int lane) {
    const f32x4* xr = (const f32x4*)xrow + lane; f32x4 v[8]; float s = 0.f;
#pragma unroll
    for (int j = 0; j < 8; ++j) { v[j] = xr[64 * j]; s += (v[j].x * v[j].x + v[j].y * v[j].y) + (v[j].z * v[j].z + v[j].w * v[j].w); }
    const float rstd = rsqrtf(wave_sum(s) * (1.f / DM) + EPS);
    const f32x4* gr = (const f32x4*)g + lane; f32x4* o = (f32x4*)orow + lane;
#pragma unroll
    for (int j = 0; j < 8; ++j) { const f32x4 gg = gr[64 * j]; o[64 * j] = (f32x4){v[j].x * rstd * gg.x, v[j].y * rstd * gg.y, v[j].z * rstd * gg.z, v[j].w * rstd * gg.w}; }
}

__device__ __forceinline__ void phase0(const Params& p, LAS unsigned char* lds, int wave_s) {
    const int tid = opaque_tid(wave_s), lane = tid & 63, wave = tid >> 6;
    const int gw = blockIdx.x * 8 + wave, NGW = gridDim.x * 8;
    LAS float* scr = (LAS float*)(lds + wave * 8448);
    unsigned char* ws = p.ws;
    convert_items(p, scr, lane, gw, NGW, 0, CV_SPLIT);
    { u32x4* z = (u32x4*)((bf16_t*)(ws + WS_WIN) + (size_t)13344 * 2048); const int n16 = 224 * 2048 * 2 / 16;
      for (int i = blockIdx.x * 512 + tid; i < n16; i += gridDim.x * 512) z[i] = (u32x4){0u, 0u, 0u, 0u}; }
    bf16_t* H = (bf16_t*)(ws + WS_H);
    for (int m = gw; m < MT; m += NGW) {
        if (m < MR) { const float* xr = (m < MP) ? p.in[0] + (size_t)m * DM : p.in[1] + (size_t)(m - MP) * DM; rms_row_bf16(xr, p.in[7], H + (size_t)m * DM, lane); }
        else { u32x2* o8 = (u32x2*)(H + (size_t)m * DM) + lane;
#pragma unroll
            for (int j = 0; j < 8; ++j) o8[64 * j] = (u32x2){0u, 0u}; }
    }
    bf16_t* PB = (bf16_t*)(ws + WS_PBF);
    for (int m = gw; m < MT; m += NGW) {
        u32x2 w = (u32x2){0u, 0u};
        if (m < MR) { const float* pr = (m < MP) ? p.in[2] + (size_t)m * 256 : p.in[3] + (size_t)(m - MP) * 256; const f32x4 v = __builtin_nontemporal_load((const f32x4*)pr + lane); w.x = pk2(v.x, v.y); w.y = pk2(v.z, v.w); }
        ((u32x2*)(PB + (size_t)m * 256))[lane] = w;
    }
    { const int n4 = MS * 14 * 256;
      for (int i = blockIdx.x * 512 + tid; i < n4; i += gridDim.x * 512) { const int s = i / (14 * 256), q = i % (14 * 256);
          ((f32x4*)(p.out + O_POOLS + (size_t)s * 15 * 1024))[q] = ((const f32x4*)(p.in[4] + (size_t)s * 15 * 1024 + 1024))[q]; }
      const int m4 = MS * 2 * 1536;
      for (int i = blockIdx.x * 512 + tid; i < m4; i += gridDim.x * 512) { const int s = i / (2 * 1536), q = i % (2 * 1536);
          ((f32x4*)(p.out + O_CONVS + (size_t)s * 3 * 6144))[q] = ((const f32x4*)(p.in[5] + (size_t)s * 3 * 6144 + 6144))[q]; } }
}

__device__ __forceinline__ void acc8(float (&sum)[8], const u32x4 v, float mk) {
    sum[0] += bflo(v.x) * mk; sum[1] += bfhi(v.x) * mk; sum[2] += bflo(v.y) * mk; sum[3] += bfhi(v.y) * mk; sum[4] += bflo(v.z) * mk; sum[5] += bfhi(v.z) * mk; sum[6] += bflo(v.w) * mk; sum[7] += bfhi(v.w) * mk;
}
template <int W>
__device__ __forceinline__ void pool_item(const Params& p, const bf16_t* PROJ, bf16_t* D, int r, int c0) {
    float sum[8], uu[8];
    const u32x4 v0 = *(const u32x4*)(PROJ + (size_t)r * NQ + c0);
    uu[0] = bflo(v0.x); uu[1] = bfhi(v0.x); uu[2] = bflo(v0.y); uu[3] = bfhi(v0.y); uu[4] = bflo(v0.z); uu[5] = bfhi(v0.z); uu[6] = bflo(v0.w); uu[7] = bfhi(v0.w);
#pragma unroll
    for (int j = 0; j < 8; ++j) sum[j] = uu[j];
    float cnt;
    if (r < MP) {
        const int t = r & 2047; cnt = (float)((t + 1 < W) ? (t + 1) : W);
        u32x4 v[W - 1];
#pragma unroll
        for (int i = 1; i < W; ++i) v[i - 1] = *(const u32x4*)(PROJ + (size_t)(r - (i <= t ? i : 0)) * NQ + c0);
#pragma unroll
        for (int i = 1; i < W; ++i) acc8(sum, v[i - 1], (i <= t) ? 1.f : 0.f);
    } else {
        const int s = r - MP; cnt = (float)W; const float* sp = p.in[4] + (size_t)s * 15 * 1024 + c0;
        f32x4 a[W - 1], b[W - 1];
#pragma unroll
        for (int i = 0; i < W - 1; ++i) { a[i] = *(const f32x4*)(sp + (size_t)(14 - i) * 1024); b[i] = *(const f32x4*)(sp + (size_t)(14 - i) * 1024 + 4); }
#pragma unroll
        for (int i = 0; i < W - 1; ++i) { sum[0] += a[i].x; sum[1] += a[i].y; sum[2] += a[i].z; sum[3] += a[i].w; sum[4] += b[i].x; sum[5] += b[i].y; sum[6] += b[i].z; sum[7] += b[i].w; }
    }
    const float inv = 1.0f / cnt; u32x4 o;
    o.x = pk2(sum[0] * inv - uu[0], sum[1] * inv - uu[1]); o.y = pk2(sum[2] * inv - uu[2], sum[3] * inv - uu[3]);
    o.z = pk2(sum[4] * inv - uu[4], sum[5] * inv - uu[5]); o.w = pk2(sum[6] * inv - uu[6], sum[7] * inv - uu[7]);
    *(u32x4*)(D + (size_t)r * 1024 + c0) = o;
}
__device__ __forceinline__ void phase_pool_d(const Params& p, int wave_s) {
    const bf16_t* PROJ = (const bf16_t*)(p.ws + WS_PROJ); bf16_t* D = (bf16_t*)(p.ws + WS_D);
    const int total = MR * 32;
    const int tid = opaque_tid(wave_s);
    for (int idx = blockIdx.x * 512 + tid; idx < total; idx += gridDim.x * 512) {
        const int r = idx >> 5, ch = idx & 31;
        pool_item<2>(p, PROJ, D, r, ch * 8);
        pool_item<4>(p, PROJ, D, r, 256 + ch * 8);
        pool_item<8>(p, PROJ, D, r, 512 + ch * 8);
        pool_item<16>(p, PROJ, D, r, 768 + ch * 8);
    }
}

__device__ __forceinline__ void conv16(const bf16_t* PROJ, const LAS float* cw, int rowbase, int t, int pcol, float (&y)[16]) {
    u32x4 a[4], b[4];
#pragma unroll
    for (int i = 0; i < 4; ++i) {
        const int tt = t - 3 + i, tc = tt < 0 ? 0 : tt;
        a[i] = *(const u32x4*)(PROJ + (size_t)(rowbase + tc) * NQ + pcol); b[i] = *(const u32x4*)(PROJ + (size_t)(rowbase + tc) * NQ + pcol + 8);
    }
#pragma unroll
    for (int j = 0; j < 16; ++j) y[j] = 0.f;
#pragma unroll
    for (int i = 0; i < 4; ++i) {
        const float mk = (t - 3 + i) >= 0 ? 1.f : 0.f;
        const f32x4 w0 = *(const LAS f32x4*)(cw + i * 128) * mk, w1 = *(const LAS f32x4*)(cw + i * 128 + 4) * mk, w2 = *(const LAS f32x4*)(cw + i * 128 + 8) * mk, w3 = *(const LAS f32x4*)(cw + i * 128 + 12) * mk;
        y[0] += bflo(a[i].x) * w0.x; y[1] += bfhi(a[i].x) * w0.y; y[2] += bflo(a[i].y) * w0.z; y[3] += bfhi(a[i].y) * w0.w;
        y[4] += bflo(a[i].z) * w1.x; y[5] += bfhi(a[i].z) * w1.y; y[6] += bflo(a[i].w) * w1.z; y[7] += bfhi(a[i].w) * w1.w;
        y[8] += bflo(b[i].x) * w2.x; y[9] += bfhi(b[i].x) * w2.y; y[10] += bflo(b[i].y) * w2.z; y[11] += bfhi(b[i].y) * w2.w;
        y[12] += bflo(b[i].z) * w3.x; y[13] += bfhi(b[i].z) * w3.y; y[14] += bflo(b[i].w) * w3.z; y[15] += bfhi(b[i].w) * w3.w;
    }
#pragma unroll
    for (int j = 0; j < 16; ++j) y[j] = siluf_(y[j]);
}

__device__ __forceinline__ void phase_chunk_prep(const Params& p, LAS unsigned char* lds, int wave_s) {
    const int tid0 = opaque_tid(wave_s);
    const bf16_t* PROJ = (const bf16_t*)(p.ws + WS_PROJ); const float* GB = (const float*)(p.ws + WS_GB);
    LAS bf16_t* KN = (LAS bf16_t*)(lds); LAS bf16_t* QN = (LAS bf16_t*)(lds + 17408);
    LAS float* AM = (LAS float*)(lds + 34816); LAS float* RHS = (LAS float*)(lds + 51200);
    LAS float* sgc = (LAS float*)(lds + 116736); LAS float* sbe = (LAS float*)(lds + 116992);
    LAS float* CW = (LAS float*)(lds + 117248);
    const int Gd = gridDim.x, per = 2048 / Gd; const bool contig = (per * Gd == 2048);
    int cur_h = -1;
    for (int uu = blockIdx.x; uu < 2048; uu += Gd) {
        const int unit = contig ? (int)blockIdx.x * per + (uu / Gd) : uu;
        int tid = tid0; asm volatile("" : "+v"(tid));
        const int lane = tid & 63, wave = tid >> 6, fr = lane & 15, fq = lane >> 4;
        const int b = unit >> 9, h = (unit >> 5) & 15, n = unit & 31;
        if (h != cur_h) { cur_h = h;
            for (int i = tid; i < 1536; i += 512) { const int which = i >> 9, tap = (i >> 7) & 3, dd = i & 127; CW[i] = p.in[11][(size_t)tap * 6144 + which * 2048 + h * 128 + dd]; }
            BAR_LDS(); }
        const int rowbase = b * SEQ, t0 = n * 64;
        bf16_t* img = (bf16_t*)(p.ws + WS_CHUNK) + (size_t)unit * IMG_ELEMS;
        float* U = p.out + O_YP + (size_t)unit * 8192;
        if (wave == 0) { const int r = rowbase + t0 + lane; float gc = GB[(size_t)r * 32 + h]; const float be = GB[(size_t)r * 32 + 16 + h];
#pragma unroll
            for (int o = 1; o < 64; o <<= 1) { const float t = bperm(gc, (lane - o) & 63); if (lane >= o) gc += t; }
            sgc[lane] = gc; sbe[lane] = be; }
        const int r = tid >> 3, seg = tid & 7, t = t0 + r;
        float q[16], k[16], v[16];
        conv16(PROJ, CW + seg * 16, rowbase, t, 1024 + h * 128 + seg * 16, q);
        conv16(PROJ, CW + 512 + seg * 16, rowbase, t, 1024 + 2048 + h * 128 + seg * 16, k);
        conv16(PROJ, CW + 1024 + seg * 16, rowbase, t, 1024 + 4096 + h * 128 + seg * 16, v);
        float sq = 0.f, sk = 0.f;
#pragma unroll
        for (int j = 0; j < 16; ++j) { sq += q[j] * q[j]; sk += k[j] * k[j]; }
#pragma unroll
        for (int o = 1; o < 8; o <<= 1) { sq += bperm(sq, lane ^ o); sk += bperm(sk, lane ^ o); }
        const float rq = rsqrtf(sq + EPS) * 0.08838834764831845f, rk = rsqrtf(sk + EPS);
#pragma unroll
        for (int j = 0; j < 16; ++j) { q[j] *= rq; k[j] *= rk; }
        BAR_LDS();
        const float gc_r = sgc[r], be_r = sbe[r], gc_last = sgc[63];
        const float eg = __expf(gc_r), et = __expf(gc_last - gc_r);
        {
            u32x4 w0, w1;
            w0.x = pk2(k[0], k[1]); w0.y = pk2(k[2], k[3]); w0.z = pk2(k[4], k[5]); w0.w = pk2(k[6], k[7]);
            w1.x = pk2(k[8], k[9]); w1.y = pk2(k[10], k[11]); w1.z = pk2(k[12], k[13]); w1.w = pk2(k[14], k[15]);
            *(LAS u32x4*)(KN + r * 136 + seg * 16) = w0; *(LAS u32x4*)(KN + r * 136 + seg * 16 + 8) = w1;
            w0.x = pk2(q[0], q[1]); w0.y = pk2(q[2], q[3]); w0.z = pk2(q[4], q[5]); w0.w = pk2(q[6], q[7]);
            w1.x = pk2(q[8], q[9]); w1.y = pk2(q[10], q[11]); w1.z = pk2(q[12], q[13]); w1.w = pk2(q[14], q[15]);
            *(LAS u32x4*)(QN + r * 136 + seg * 16) = w0; *(LAS u32x4*)(QN + r * 136 + seg * 16 + 8) = w1;
            w0.x = pk2(q[0] * eg, q[1] * eg); w0.y = pk2(q[2] * eg, q[3] * eg); w0.z = pk2(q[4] * eg, q[5] * eg); w0.w = pk2(q[6] * eg, q[7] * eg);
            w1.x = pk2(q[8] * eg, q[9] * eg); w1.y = pk2(q[10] * eg, q[11] * eg); w1.z = pk2(q[12] * eg, q[13] * eg); w1.w = pk2(q[14] * eg, q[15] * eg);
            { bf16_t* qd = img + IMG_QD + r * SWD + seg * 16;
              *(u32x2*)(qd) = (u32x2){w0.x, w0.y}; *(u32x2*)(qd + 4) = (u32x2){w0.z, w0.w}; *(u32x2*)(qd + 8) = (u32x2){w1.x, w1.y}; *(u32x2*)(qd + 12) = (u32x2){w1.z, w1.w}; }
        }
#pragma unroll
        for (int j = 0; j < 16; ++j) { RHS[r * 256 + seg * 16 + j] = v[j] * be_r; RHS[r * 256 + 128 + seg * 16 + j] = k[j] * be_r * eg; }
#pragma unroll
        for (int j = 0; j < 16; ++j) img[IMG_KT + (seg * 16 + j) * SKT + r] = f2bf(k[j] * et);
        if (tid == 0) ((float*)(p.ws + WS_GL))[unit] = __expf(gc_last);
        BAR_LDS();
        {
            const int m = wave & 3; const LAS bf16_t* Arows = (wave < 4) ? KN : QN;
            bf16x8 af[4];
#pragma unroll
            for (int s = 0; s < 4; ++s) af[s] = *(const LAS bf16x8*)(Arows + (16 * m + fr) * 136 + 32 * s + 8 * fq);
#pragma unroll
            for (int nt = 0; nt < 4; ++nt) {
                f32x4 c = (f32x4){0.f, 0.f, 0.f, 0.f};
#pragma unroll
                for (int s = 0; s < 4; ++s) { const bf16x8 bfr = *(const LAS bf16x8*)(KN + (16 * nt + fr) * 136 + 32 * s + 8 * fq); c = __builtin_amdgcn_mfma_f32_16x16x32_bf16(af[s], bfr, c, 0, 0, 0); }
                const int j = 16 * nt + fr; const float gcj = sgc[j];
#pragma unroll
                for (int rg = 0; rg < 4; ++rg) { const int i = 16 * m + 4 * fq + rg; const float gci = sgc[i];
                    if (wave < 4) { const float a = (i > j) ? sbe[i] * c[rg] * __expf(gci - gcj) : 0.f; AM[i * 64 + j] = a; }
                    else { const float a = (i >= j) ? c[rg] * __expf(gci - gcj) : 0.f; img[IMG_QK + i * SKT + j] = f2bf(a); } }
            }
        }
        BAR_LDS();
        if (tid < 256) {
            const int col = tid; float sol[64];
#pragma unroll
            for (int i = 0; i < 64; ++i) sol[i] = 0.f;
#pragma unroll
            for (int i = 0; i < 64; ++i) {
                float s0 = RHS[i * 256 + col], s1 = 0.f, s2 = 0.f, s3 = 0.f;
#pragma unroll
                for (int j4 = 0; j4 < (i + 3) / 4; ++j4) { const f32x4 a = *(const LAS f32x4*)(AM + i * 64 + 4 * j4);
                    s0 -= a.x * sol[4 * j4]; s1 -= a.y * sol[4 * j4 + 1]; s2 -= a.z * sol[4 * j4 + 2]; s3 -= a.w * sol[4 * j4 + 3]; }
                sol[i] = (s0 + s1) + (s2 + s3);
            }
            if (col < 128) {
#pragma unroll
                for (int mm = 0; mm < 4; ++mm)
#pragma unroll
                    for (int q4 = 0; q4 < 4; ++q4)
                        *(f32x4*)(U + ((((col >> 4) * 4 + mm) * 64 + q4 * 16 + (col & 15)) << 2)) = (f32x4){sol[16 * mm + 4 * q4], sol[16 * mm + 4 * q4 + 1], sol[16 * mm + 4 * q4 + 2], sol[16 * mm + 4 * q4 + 3]};
            } else {
#pragma unroll
                for (int i = 0; i < 64; ++i) img[IMG_WD + i * SWD + (col - 128)] = f2bf(sol[i]);
            }
        }
        BAR_LDS();
    }
    __syncthreads();
}

__device__ __forceinline__ bf16x8 acc2frag(const f32x4 a, const f32x4 b) {
    u32x4 w; w.x = pk2(a[0], a[1]); w.y = pk2(a[2], a[3]); w.z = pk2(b[0], b[1]); w.w = pk2(b[2], b[3]);
    return __builtin_bit_cast(bf16x8, w);
}
__device__ __forceinline__ bf16x8 ldfrag(const LAS bf16_t* p) {
    const u32x2 a = *(const LAS u32x2*)p, b = *(const LAS u32x2*)(p + 16);
    u32x4 w; w.x = a.x; w.y = a.y; w.z = b.x; w.w = b.y; return __builtin_bit_cast(bf16x8, w);
}
__device__ __forceinline__ void phase_scan(const Params& p, LAS unsigned char* lds, int bh, int wave_s) {
    const int tid = opaque_tid(wave_s), lane = tid & 63, wave = __builtin_amdgcn_readfirstlane(tid >> 6), fr = lane & 15, fq = lane >> 4;
    const int b = bh >> 4, h = bh & 15, e0 = wave * 16;
    const bf16_t* PROJ = (const bf16_t*)(p.ws + WS_PROJ); bf16_t* GDN = (bf16_t*)(p.ws + WS_GDNOUT);
    const float* GL = (const float*)(p.ws + WS_GL);
    LAS float* SCR = (LAS float*)(lds + 2 * IMG_BYTES);
    const float gnorm = p.in[14][e0 + fr];
    f32x4 Sacc[8];
#pragma unroll
    for (int m = 0; m < 8; ++m) Sacc[m] = (f32x4){0.f, 0.f, 0.f, 0.f};
    const int unit0 = bh * 32;
    const unsigned char* chunk0 = (const unsigned char*)(p.ws + WS_CHUNK) + (size_t)unit0 * IMG_BYTES;
    const float* U0 = p.out + O_YP + (size_t)unit0 * 8192 + ((wave * 256 + lane) << 2);
    const bf16_t* Z0 = PROJ + ((size_t)b * SEQ + (tid >> 3)) * NQ + 7168 + h * 128 + (tid & 7) * 16;
    LAS bf16_t* ZT = (LAS bf16_t*)(lds + 2 * IMG_BYTES + 4096);
    LAS bf16_t* ztw = ZT + (tid >> 3) * 136 + (tid & 7) * 16;
#define SCAN_COPY(srcbase, bufidx) do { _Pragma("unroll") for (int k = 0; k < 8; ++k) { const int pc = wave + 8 * k; if (pc < IMG_PIECES) \
        __builtin_amdgcn_global_load_lds((const unsigned*)((srcbase) + pc * 1024 + lane * 16), (LAS unsigned*)(lds + (bufidx) * IMG_BYTES + pc * 1024), 16, 0, 0); } } while (0)
#define SCAN_LOAD(n_, uu, z0, z1, gl) do { const float* U_ = U0 + (size_t)(n_) * 8192; const bf16_t* Z_ = Z0 + (size_t)(n_) * 64 * NQ; \
        z0 = *(const u32x4*)Z_; z1 = *(const u32x4*)(Z_ + 8); \
        _Pragma("unroll") for (int mm = 0; mm < 4; ++mm) uu[mm] = *(const f32x4*)(U_ + mm * 256); \
        gl = GL[unit0 + (n_)]; } while (0)
    SCAN_COPY(chunk0, 0);
    f32x4 ucur[4]; float glcur; u32x4 zr0, zr1;
    SCAN_LOAD(0, ucur, zr0, zr1, glcur);
    asm volatile("s_waitcnt vmcnt(0)" ::: "memory");
    *(LAS u32x4*)ztw = zr0; *(LAS u32x4*)(ztw + 8) = zr1;
    BAR_LDS();
    for (int n = 0; n < 32; ++n) {
        const int cur = n & 1;
        const LAS bf16_t* img = (const LAS bf16_t*)(lds + cur * IMG_BYTES);
        const bool hasn = (n + 1 < 32);
        f32x4 unext[4]; float glnext = 0.f;
        { const int np = hasn ? n + 1 : n;
          SCAN_COPY(chunk0 + (size_t)np * IMG_BYTES, cur ^ 1); SCAN_LOAD(np, unext, zr0, zr1, glnext); }
        bf16_t ov[16];
        bf16x8 Sb[4];
#pragma unroll
        for (int s = 0; s < 4; ++s) Sb[s] = acc2frag(Sacc[2 * s], Sacc[2 * s + 1]);
        f32x4 vn[4], o[4];
        bf16x8 wf[2][4], qf[2][4];
#pragma unroll
        for (int s = 0; s < 4; ++s) { wf[0][s] = ldfrag(img + IMG_WD + fr * SWD + 32 * s + 4 * fq); qf[0][s] = ldfrag(img + IMG_QD + fr * SWD + 32 * s + 4 * fq); }
#pragma unroll
        for (int mm = 0; mm < 4; ++mm) {
            if (mm < 3) {
#pragma unroll
                for (int s = 0; s < 4; ++s) { wf[(mm + 1) & 1][s] = ldfrag(img + IMG_WD + (16 * (mm + 1) + fr) * SWD + 32 * s + 4 * fq); qf[(mm + 1) & 1][s] = ldfrag(img + IMG_QD + (16 * (mm + 1) + fr) * SWD + 32 * s + 4 * fq); } }
            f32x4 c = (f32x4){0.f, 0.f, 0.f, 0.f}, d = (f32x4){0.f, 0.f, 0.f, 0.f};
#pragma unroll
            for (int s = 0; s < 4; ++s) {
                c = __builtin_amdgcn_mfma_f32_16x16x32_bf16(wf[mm & 1][s], Sb[s], c, 0, 0, 0);
                d = __builtin_amdgcn_mfma_f32_16x16x32_bf16(qf[mm & 1][s], Sb[s], d, 0, 0, 0);
            }
            vn[mm] = ucur[mm] - c; o[mm] = d;
        }
        bf16x8 kq[4][2], kt[4][2];
#pragma unroll
        for (int mm = 0; mm < 4; ++mm)
#pragma unroll
            for (int s = 0; s < 2; ++s) kq[mm][s] = ldfrag(img + IMG_QK + (16 * mm + fr) * SKT + 32 * s + 4 * fq);
#pragma unroll
        for (int m = 0; m < 4; ++m)
#pragma unroll
            for (int s = 0; s < 2; ++s) kt[m][s] = ldfrag(img + IMG_KT + (16 * m + fr) * SKT + 32 * s + 4 * fq);
        bf16x8 vb[2];
#pragma unroll
        for (int s = 0; s < 2; ++s) vb[s] = acc2frag(vn[2 * s], vn[2 * s + 1]);
#pragma unroll
        for (int mm = 0; mm < 4; ++mm)
#pragma unroll
            for (int s = 0; s < 2; ++s) o[mm] = __builtin_amdgcn_mfma_f32_16x16x32_bf16(kq[mm][s], vb[s], o[mm], 0, 0, 0);
#pragma unroll
        for (int m = 0; m < 4; ++m)
#pragma unroll
            for (int s = 0; s < 2; ++s) kq[m][s] = ldfrag(img + IMG_KT + (16 * (m + 4) + fr) * SKT + 32 * s + 4 * fq);
#pragma unroll
        for (int m = 0; m < 4; ++m) {
            f32x4 c = Sacc[m] * glcur;
#pragma unroll
            for (int s = 0; s < 2; ++s) c = __builtin_amdgcn_mfma_f32_16x16x32_bf16(kt[m][s], vb[s], c, 0, 0, 0);
            Sacc[m] = c;
        }
#pragma unroll
        for (int m = 0; m < 4; ++m) {
            f32x4 c = Sacc[m + 4] * glcur;
#pragma unroll
            for (int s = 0; s < 2; ++s) c = __builtin_amdgcn_mfma_f32_16x16x32_bf16(kq[m][s], vb[s], c, 0, 0, 0);
            Sacc[m + 4] = c;
        }
#pragma unroll
        for (int mm = 0; mm < 4; ++mm)
#pragma unroll
            for (int rg = 0; rg < 4; ++rg) { const float sr = dpp_sum16(o[mm][rg] * o[mm][rg]);
                if (fr == 0) SCR[(16 * mm + 4 * fq + rg) * 8 + wave] = sr; }
        BAR_LDS();
        { LAS float* RS = SCR + 512 + wave * 64;
          const f32x4 p0 = *(const LAS f32x4*)(SCR + lane * 8), p1 = *(const LAS f32x4*)(SCR + lane * 8 + 4);
          const float ssq = ((p0.x + p0.y) + (p0.z + p0.w)) + ((p1.x + p1.y) + (p1.z + p1.w));
          RS[lane] = rsqrtf(ssq * (1.f / 128.f) + EPS);
          asm volatile("s_waitcnt lgkmcnt(0)" ::: "memory");
#pragma unroll
          for (int mm = 0; mm < 4; ++mm) { const f32x4 rs = *(const LAS f32x4*)(RS + 16 * mm + 4 * fq);
#pragma unroll
              for (int rg = 0; rg < 4; ++rg) ov[mm * 4 + rg] = f2bf(o[mm][rg] * rs[rg] * gnorm * siluf_(bf2f(ZT[(16 * mm + 4 * fq + rg) * 136 + e0 + fr]))); } }
        asm volatile("s_waitcnt vmcnt(0)" ::: "memory");
        { bf16_t* gp = GDN + ((size_t)b * SEQ + n * 64) * DM + h * 128 + e0 + fr;
#pragma unroll
          for (int mm = 0; mm < 4; ++mm)
#pragma unroll
              for (int rg = 0; rg < 4; ++rg) gp[(size_t)(16 * mm + 4 * fq + rg) * DM] = ov[mm * 4 + rg]; }
        BAR_LDS();
        *(LAS u32x4*)ztw = zr0; *(LAS u32x4*)(ztw + 8) = zr1;
#pragma unroll
        for (int mm = 0; mm < 4; ++mm) ucur[mm] = unext[mm];
        glcur = glnext;
    }
#undef SCAN_COPY
#undef SCAN_LOAD
    float* so = p.out + O_SSMP + (size_t)bh * 16384;
#pragma unroll
    for (int m = 0; m < 8; ++m)
#pragma unroll
        for (int rg = 0; rg < 4; ++rg) so[(16 * m + 4 * fq + rg) * 128 + e0 + fr] = Sacc[m][rg];
    __syncthreads();
}

struct SamplePre { float sraw[32]; float cw[4]; float sc[3]; bf16_t pj; float g, be; bf16_t z; };
__device__ __forceinline__ void sample_load(const Params& p, int su, int tid, SamplePre& P) {
    const int s = su >> 4, h = su & 15, e = tid & 127, dg = tid >> 7; const size_t prow = (size_t)(MP + s);
    const bf16_t* PROJ = (const bf16_t*)(p.ws + WS_PROJ); const float* GB = (const float*)(p.ws + WS_GB);
    const float* S0 = p.in[6] + (size_t)su * 16384 + (size_t)(dg * 32) * 128 + e;
#pragma unroll
    for (int i = 0; i < 32; ++i) P.sraw[i] = __builtin_nontemporal_load(&S0[i * 128]);
    { const int ch = tid < 384 ? tid : 0; const int which = ch >> 7, dd = ch & 127, col = which * 2048 + h * 128 + dd;
      const float* cw = p.in[11] + col; const float* sc = p.in[5] + (size_t)s * 3 * 6144 + col;
      P.cw[0] = cw[0]; P.cw[1] = cw[6144]; P.cw[2] = cw[2 * 6144]; P.cw[3] = cw[3 * 6144];
      P.sc[0] = sc[0]; P.sc[1] = sc[6144]; P.sc[2] = sc[2 * 6144]; P.pj = PROJ[prow * NQ + 1024 + col]; }
    P.g = GB[prow * 32 + h]; P.be = GB[prow * 32 + 16 + h];
    P.z = PROJ[prow * NQ + 7168 + h * 128 + e];
}
__device__ __forceinline__ void phase_sample(const Params& p, LAS unsigned char* lds, int c, int G, int wave_s) {
    const int tid = opaque_tid(wave_s), lane = tid & 63, wave = tid >> 6;
    bf16_t* GDN = (bf16_t*)(p.ws + WS_GDNOUT);
    LAS float* vals = (LAS float*)lds;
    LAS float* part = vals + 384;
    LAS float* red = part + 8;
    LAS float* red2 = red + 512;
    LAS float* part2 = red2 + 512;
    const int e = tid & 127, dg = tid >> 7;
    const float gn = p.in[14][e];
    SamplePre cur, nx;
    if (c < 2048) sample_load(p, c, tid, cur);
    for (int su = c; su < 2048; su += G) {
        const int s = su >> 4, h = su & 15; const size_t prow = (size_t)(MP + s);
        const bool hasn = (su + G < 2048);
        if (hasn) sample_load(p, su + G, tid, nx);
        float y = 0.f;
        if (tid < 384) { y = cur.cw[0] * cur.sc[0] + cur.cw[1] * cur.sc[1] + cur.cw[2] * cur.sc[2] + cur.cw[3] * bf2f(cur.pj); y = siluf_(y); vals[tid] = y; }
        { const float ss = wave_sum(y * y); if (lane == 0) part[wave] = ss; }
        BAR_LDS();
        const float rq = rsqrtf(part[0] + part[1] + EPS) * 0.08838834764831845f, rk = rsqrtf(part[2] + part[3] + EPS);
        const float eg = __expf(cur.g), be = cur.be;
        float Sd[32]; float ks = 0.f;
#pragma unroll
        for (int i = 0; i < 32; ++i) Sd[i] = cur.sraw[i] * eg;
#pragma unroll
        for (int i = 0; i < 32; ++i) ks += vals[128 + dg * 32 + i] * rk * Sd[i];
        red[dg * 128 + e] = ks;
        BAR_LDS();
        const float kS = (red[e] + red[128 + e]) + (red[256 + e] + red[384 + e]);
        const float vnew = be * (vals[256 + e] - kS);
        float* So = p.out + O_SSMS + (size_t)su * 16384 + (size_t)(dg * 32) * 128 + e;
        float os = 0.f;
#pragma unroll
        for (int i = 0; i < 32; ++i) { const float sn = Sd[i] + vals[128 + dg * 32 + i] * rk * vnew; __builtin_nontemporal_store(sn, &So[i * 128]); os += vals[dg * 32 + i] * rq * sn; }
        red2[dg * 128 + e] = os;
        BAR_LDS();
        float o = 0.f;
        if (tid < 128) { o = (red2[e] + red2[128 + e]) + (red2[256 + e] + red2[384 + e]); const float ss = wave_sum(o * o); if (lane == 0) part2[wave] = ss; }
        BAR_LDS();
        if (tid < 128) { const float rstd = rsqrtf((part2[0] + part2[1]) * (1.f / 128.f) + EPS);
            GDN[prow * DM + h * 128 + e] = f2bf(o * rstd * gn * siluf_(bf2f(cur.z))); }
        BAR_LDS();
        cur = nx;
    }
    __syncthreads();
}

__device__ __forceinline__ f32x4 mini_acc(const bf16_t* A, int lda, const bf16_t* Bt, int ldb, int K, int n0, int wave, int fr, int fq, LAS unsigned char* lds) {
    asm volatile("" : "+s"(lda), "+s"(ldb));
    const int lane = fq * 16 + fr, ks = K >> 3;
    const bf16_t* ap = A + (size_t)(MP + fr) * lda + wave * ks + 8 * fq;
    const bf16_t* bp = Bt + (size_t)(n0 + fr) * ldb + wave * ks + 8 * fq;
    f32x4 acc[8];
#pragma unroll
    for (int m = 0; m < 8; ++m) acc[m] = (f32x4){0.f, 0.f, 0.f, 0.f};
    for (int k = 0; k < ks; k += 64) {
        const bool two = (k + 32 < ks);
        bf16x8 bq[2], aq[2][8];
        bq[0] = *(const bf16x8*)(bp + k);
#pragma unroll
        for (int m = 0; m < 8; ++m) aq[0][m] = *(const bf16x8*)(ap + (size_t)(16 * m) * lda + k);
        if (two) { bq[1] = *(const bf16x8*)(bp + k + 32);
#pragma unroll
            for (int m = 0; m < 8; ++m) aq[1][m] = *(const bf16x8*)(ap + (size_t)(16 * m) * lda + k + 32); }
#pragma unroll
        for (int m = 0; m < 8; ++m) acc[m] = __builtin_amdgcn_mfma_f32_16x16x32_bf16(bq[0], aq[0][m], acc[m], 0, 0, 0);
        if (two) {
#pragma unroll
            for (int m = 0; m < 8; ++m) acc[m] = __builtin_amdgcn_mfma_f32_16x16x32_bf16(bq[1], aq[1][m], acc[m], 0, 0, 0); }
    }
    LAS f32x4* RED = (LAS f32x4*)lds;
#pragma unroll
    for (int m = 0; m < 8; ++m) RED[(wave * 8 + m) * 64 + lane] = acc[m];
    BAR_LDS();
    f32x4 r = (f32x4){0.f, 0.f, 0.f, 0.f};
#pragma unroll
    for (int w2 = 0; w2 < 8; ++w2) r += RED[(w2 * 8 + wave) * 64 + lane];
    BAR_LDS();
    return r;
}
__device__ __forceinline__ f32x4 bf4_to_f32(u32x2 w) { return (f32x4){bflo(w.x), bfhi(w.x), bflo(w.y), bfhi(w.y)}; }
__device__ __forceinline__ u32x2 f32_to_bf4(f32x4 v) { u32x2 w; w.x = pk2(v[0], v[1]); w.y = pk2(v[2], v[3]); return w; }

#define XB_XCNT(j)  (256  + 64 * (j))
#define XB_XSUB(j)  (1280 + 64 * (j))
#define XB_XGEN(j)  (2304 + 64 * (j))
#define XB_TOP      3328
#define XB_TOPGEN   3392
#define XCD_BAR_WORDS 3456
__device__ __forceinline__ unsigned xb_ld(unsigned* p)              { return __hip_atomic_load(p, __ATOMIC_RELAXED, __HIP_MEMORY_SCOPE_AGENT); }
__device__ __forceinline__ unsigned xb_add(unsigned* p, unsigned v) { return __hip_atomic_fetch_add(p, v, __ATOMIC_RELAXED, __HIP_MEMORY_SCOPE_AGENT); }
__device__ __forceinline__ unsigned xb_xcc_id() { return (unsigned)__builtin_amdgcn_s_getreg((3 << 11) | 20) & 0xFu; }
__device__ __forceinline__ void xcd_barrier(unsigned* bar, volatile LAS unsigned* st, int wave_s) {
    asm volatile("s_waitcnt vmcnt(0)" ::: "memory");
    __syncthreads();
    if (opaque_tid(wave_s) == 0) {
        __builtin_amdgcn_s_waitcnt(0);
        const unsigned x = xb_xcc_id();
        unsigned nloc = st[0], nx = st[1];
        if (nloc == 0u) {
            const unsigned G = gridDim.x; unsigned sum, cnt, mine;
            for (;;) { sum = 0u; cnt = 0u; mine = 0u;
#pragma unroll
                for (unsigned j = 0; j < 16; ++j) { const unsigned c = xb_ld(&bar[XB_XCNT(j)]); sum += c; cnt += (c > 0u) ? 1u : 0u; mine = (j == x) ? c : mine; }
                if (sum == G) break;
                __builtin_amdgcn_s_sleep(1); }
            nloc = mine > 0u ? mine : 1u; nx = cnt > 0u ? cnt : 1u; st[0] = nloc; st[1] = nx; }
        const unsigned old = xb_add(&bar[XB_XSUB(x)], 1u);
        const unsigned gen = old / nloc;
        if (old + 1u == (gen + 1u) * nloc) {
            __builtin_amdgcn_fence(__ATOMIC_RELEASE, "agent");
            asm volatile("s_waitcnt vmcnt(0)" ::: "memory");
            const unsigned og = xb_add(&bar[XB_TOP], 1u);
            const unsigned tg = og / nx;
            if (og + 1u == (tg + 1u) * nx) xb_add(&bar[XB_TOPGEN], 1u);
            else { while (xb_ld(&bar[XB_TOPGEN]) == tg) __builtin_amdgcn_s_sleep(1); }
            __builtin_amdgcn_fence(__ATOMIC_ACQUIRE, "agent");
            xb_add(&bar[XB_XGEN(x)], 1u);
            asm volatile("s_waitcnt vmcnt(0)" ::: "memory");
        } else {
            while (xb_ld(&bar[XB_XGEN(x)]) == gen) __builtin_amdgcn_s_sleep(1);
            __builtin_amdgcn_fence(__ATOMIC_ACQUIRE, "agent");
            asm volatile("s_waitcnt vmcnt(0)" ::: "memory");
        }
    }
    __syncthreads();
}
__global__ void __launch_bounds__(512, 2) mega(Params p) {
    extern __shared__ __attribute__((aligned(16))) unsigned char lds_raw[];
    LAS unsigned char* lds = (LAS unsigned char*)lds_raw;
    unsigned* bar = (unsigned*)(p.ws + WS_BAR);
    volatile LAS unsigned* bst = (volatile LAS unsigned*)(lds + LDS_BYTES - 16);
    if (p.ph_lo < 0) { cg::this_grid().sync(); }
    const int lo = p.ph_lo, hi = p.ph_hi;
    const int G = gridDim.x, bx = blockIdx.x;
    const int wave_s = __builtin_amdgcn_readfirstlane(threadIdx.x >> 6);
    if (threadIdx.x == 0) { bst[0] = 0u; bst[1] = 0u; (void)xb_add(&bar[XB_XCNT(xb_xcc_id())], 1u); }
    __syncthreads();
    unsigned char* ws = p.ws;
#define IN(k) (lo <= (k) && (k) < hi)
#define SEAM(k) do { if (IN(k) && IN((k) + 1)) xcd_barrier(bar, bst, wave_s); } while (0)

    if (IN(0)) { phase0(p, lds, wave_s); }
    SEAM(0);
    if (IN(1)) {
        pg8::Gemm g{(const bf16_t*)(ws + WS_H), (const bf16_t*)(ws + WS_WIN), DM, DM, DM, 33, 53, 0};
        pg8::StaticOrder S; S.init(33, 53, G, bx);
        EpiProj E{(bf16_t*)(ws + WS_PROJ), (bf16_t*)(ws + WS_GATES), (float*)(ws + WS_GB), p.in[12], p.in[13], p.out};
        pg8::gemm_phase(lds, g, S, E, wave_s);
    }
    SEAM(1);
    if (IN(2)) { phase_pool_d(p, wave_s); phase_chunk_prep(p, lds, wave_s); }
    SEAM(2);
    if (IN(3)) {
        if (bx < 64) phase_scan(p, lds, bx, wave_s);
        else {
            phase_sample(p, lds, bx - 64, G - 64, wave_s);
            pg8::Gemm g{(const bf16_t*)(ws + WS_D), (const bf16_t*)(ws + WS_WPOOL), 1024, 256, 256, 33, 4, 256};
            pg8::StaticOrder S; S.init(33, 4, G - 64, bx - 64);
            EpiPoolGrp E{(bf16_t*)(ws + WS_POOLOUT), p.in[10]};
            pg8::gemm_phase(lds, g, S, E, wave_s);
            { const int tid = opaque_tid(wave_s), lane = tid & 63, wave = tid >> 6;
              convert_items(p, (LAS float*)(lds + wave * 8448), lane, (bx - 64) * 8 + wave, (G - 64) * 8, CV_SPLIT, CV_END); }
        }
    }
    SEAM(3);
    if (IN(4)) {
        { pg8::Gemm g{(const bf16_t*)(ws + WS_POOLOUT), (const bf16_t*)(ws + WS_WPU), 1024, 1024, 1024, 32, 8, 0};
          pg8::StaticOrder S; S.init(32, 8, G, bx);
          EpiPoolUp E{(bf16_t*)(ws + WS_T1), (const bf16_t*)(ws + WS_GATES)};
          pg8::gemm_phase(lds, g, S, E, wave_s); }
        { pg8::Gemm g{(const bf16_t*)(ws + WS_GDNOUT), (const bf16_t*)(ws + WS_WGU), DM, DM, DM, 32, 8, 0};
          pg8::StaticOrder S; S.init(32, 8, G, bx);
          EpiMerge E{(const bf16_t*)(ws + WS_T1), (const bf16_t*)(ws + WS_GATES), (bf16_t*)(ws + WS_MERGED)};
          pg8::gemm_phase(lds, g, S, E, wave_s); }
        {
            const int tid = opaque_tid(wave_s), lane = tid & 63, wave = tid >> 6, fr = lane & 15, fq = lane >> 4;
            for (int nt = bx; nt < 128; nt += G) { const int n0 = nt * 16; const f32x4 z4 = (f32x4){0.f, 0.f, 0.f, 0.f};
                const f32x4 a1 = mini_acc((const bf16_t*)(ws + WS_POOLOUT), 1024, (const bf16_t*)(ws + WS_WPU), 1024, 1024, n0, wave, fr, fq, lds);
                const f32x4 a2 = mini_acc((const bf16_t*)(ws + WS_GDNOUT), DM, (const bf16_t*)(ws + WS_WGU), DM, DM, n0, wave, fr, fq, lds);
                const size_t r = MP + 16 * wave + fr; const int c = n0 + 4 * fq;
                const f32x4 gp = bf4_to_f32(*(const u32x2*)((const bf16_t*)(ws + WS_GATES) + r * NG + c)), gg = bf4_to_f32(*(const u32x2*)((const bf16_t*)(ws + WS_GATES) + r * NG + 2048 + c));
                *(u32x2*)((bf16_t*)(ws + WS_MERGED) + r * DM + c) = f32_to_bf4(gp * a1 + gg * a2); }
        }
    }
    SEAM(4);
    if (IN(5)) {
        { pg8::Gemm g{(const bf16_t*)(ws + WS_MERGED), (const bf16_t*)(ws + WS_WO), DM, DM, DM, 32, 8, 0};
          pg8::StaticOrder S; S.init(32, 8, G, bx);
          EpiWo E{p.in[0], p.in[1], (bf16_t*)(ws + WS_X1)};
          pg8::gemm_phase(lds, g, S, E, wave_s); }
        {
            const int tid = opaque_tid(wave_s), lane = tid & 63, wave = tid >> 6, fr = lane & 15, fq = lane >> 4;
            for (int nt = bx; nt < 128; nt += G) { const int n0 = nt * 16;
                const f32x4 a1 = mini_acc((const bf16_t*)(ws + WS_MERGED), DM, (const bf16_t*)(ws + WS_WO), DM, DM, n0, wave, fr, fq, lds);
                const size_t r = MP + 16 * wave + fr; const int c = n0 + 4 * fq;
                *(u32x2*)((bf16_t*)(ws + WS_X1) + r * DM + c) = f32_to_bf4(*(const f32x4*)(p.in[1] + (r - MP) * DM + c) + a1); }
        }
    }
    SEAM(5);
    if (IN(6)) {
        const int tid = opaque_tid(wave_s), lane = tid & 63, wave = tid >> 6;
        const int gw = bx * 8 + wave, NGW = G * 8;
        for (int m = gw; m < MT; m += NGW) rms_row_b2b((const bf16_t*)(ws + WS_X1) + (size_t)m * DM, p.in[18], (bf16_t*)(ws + WS_H2) + (size_t)m * DM, lane);
    }
    SEAM(6);
    if (IN(7)) {
        pg8::Gemm g{(const bf16_t*)(ws + WS_H2), (const bf16_t*)(ws + WS_WGATE), DM, DM, DM, 33, 44, 0};
        pg8::StaticOrder S; S.init(33, 44, G, bx);
        EpiGateUp E{(bf16_t*)(ws + WS_ACT)};
        pg8::gemm_phase(lds, g, S, E, wave_s);
    }
    SEAM(7);
    if (IN(8)) {
        { pg8::Gemm g{(const bf16_t*)(ws + WS_ACT), (const bf16_t*)(ws + WS_WDOWN), DFF, DFF, DFF, 32, 8, 0};
          pg8::StaticOrder S; S.init(32, 8, G, bx);
          EpiDown E{(const bf16_t*)(ws + WS_X1), (bf16_t*)(ws + WS_X2B)};
          pg8::gemm_phase(lds, g, S, E, wave_s); }
        {
            const int tid = opaque_tid(wave_s), lane = tid & 63, wave = tid >> 6, fr = lane & 15, fq = lane >> 4;
            for (int nt = bx; nt < 128; nt += G) { const int n0 = nt * 16;
                const f32x4 a1 = mini_acc((const bf16_t*)(ws + WS_ACT), DFF, (const bf16_t*)(ws + WS_WDOWN), DFF, DFF, n0, wave, fr, fq, lds);
                const size_t r = MP + 16 * wave + fr; const int c = n0 + 4 * fq;
                const f32x4 x2 = bf4_to_f32(*(const u32x2*)((const bf16_t*)(ws + WS_X1) + r * DM + c)) + a1;
                *(u32x2*)((bf16_t*)(ws + WS_X2B) + r * DM + c) = f32_to_bf4(x2); }
        }
    }
    SEAM(8);
    if (IN(9)) {
        { pg8::Gemm g{(const bf16_t*)(ws + WS_PBF), (const bf16_t*)(ws + WS_WPLE), 256, 256, 256, 32, 8, 0};
          pg8::StaticOrder S; S.init(32, 8, G, bx);
          EpiPle E{(bf16_t*)(ws + WS_T2)};
          pg8::gemm_phase(lds, g, S, E, wave_s); }
        { pg8::Gemm g{(const bf16_t*)(ws + WS_X2B), (const bf16_t*)(ws + WS_WPLEG), DM, DM, DM, 32, 8, 0};
          pg8::StaticOrder S; S.init(32, 8, G, bx);
          EpiPleGate E{(bf16_t*)(ws + WS_X1), (const bf16_t*)(ws + WS_X2B), (const bf16_t*)(ws + WS_T2)};
          pg8::gemm_phase(lds, g, S, E, wave_s); }
        {
            const int tid = opaque_tid(wave_s), lane = tid & 63, wave = tid >> 6, fr = lane & 15, fq = lane >> 4;
            for (int nt = bx; nt < 128; nt += G) { const int n0 = nt * 16; const f32x4 z4 = (f32x4){0.f, 0.f, 0.f, 0.f};
                const f32x4 a1 = mini_acc((const bf16_t*)(ws + WS_PBF), 256, (const bf16_t*)(ws + WS_WPLE), 256, 256, n0, wave, fr, fq, lds);
                const f32x4 a2 = mini_acc((const bf16_t*)(ws + WS_X2B), DM, (const bf16_t*)(ws + WS_WPLEG), DM, DM, n0, wave, fr, fq, lds);
                const size_t r = MP + 16 * wave + fr; const int c = n0 + 4 * fq;
                f32x4 x3 = bf4_to_f32(*(const u32x2*)((const bf16_t*)(ws + WS_X2B) + r * DM + c));
#pragma unroll
                for (int j = 0; j < 4; ++j) x3[j] += a1[j] * sigmoidf_(a2[j]);
                *(u32x2*)((bf16_t*)(ws + WS_X1) + r * DM + c) = f32_to_bf4(x3); }
        }
    }
    SEAM(9);
    if (IN(10)) {
        const int tid = opaque_tid(wave_s), lane = tid & 63, wave = tid >> 6;
        const int gw = bx * 8 + wave, NGW = G * 8;
        for (int m = gw; m < MR; m += NGW) {
            float* dst = (m < MP) ? p.out + O_YP + (size_t)m * DM : p.out + O_YS + (size_t)(m - MP) * DM;
            rms_row_b2f((const bf16_t*)(ws + WS_X1) + (size_t)m * DM, p.in[23], dst, lane);
        }
    }
#undef IN
#undef SEAM
}

extern "C" void kernel_launch(void* const* d_in, const int* in_sizes, int n_in, void* d_out, int out_size, void* d_ws, size_t ws_size, hipStream_t stream) {
    static int grid = 0;
    if (grid == 0) {
        if (n_in != 24 || ws_size < WS_END) { fprintf(stderr, "kernel_launch: need 24 inputs and %zu bytes of workspace (got %d, %zu)\n", (size_t)WS_END, n_in, ws_size); grid = -1; return; }
        int dev = 0, cus = 0, per_cu = 0;
        hipGetDevice(&dev); hipDeviceGetAttribute(&cus, hipDeviceAttributeMultiprocessorCount, dev);
        if (hipFuncSetAttribute((const void*)mega, hipFuncAttributeMaxDynamicSharedMemorySize, LDS_BYTES) != hipSuccess) { fprintf(stderr, "kernel_launch: hipFuncSetAttribute failed\n"); grid = -1; return; }
        hipOccupancyMaxActiveBlocksPerMultiprocessor(&per_cu, (const void*)mega, 512, LDS_BYTES);
        (void)hipGetLastError();
        if (per_cu < 1) per_cu = 1;
        grid = cus * per_cu;
        if (grid < 128) grid = 128;
    }
    if (grid < 0) return;
    if (hipMemsetAsync((char*)d_ws + WS_BAR, 0, 16384, stream) != hipSuccess) { fprintf(stderr, "memset failed\n"); return; }
    Params p{};
    for (int i = 0; i < 24; ++i) p.in[i] = (const float*)d_in[i];
    p.out = (float*)d_out; p.ws = (unsigned char*)d_ws; p.ph_lo = 0; p.ph_hi = 11;
    void* args[] = {&p};
    hipError_t e = hipLaunchCooperativeKernel((const void*)mega, dim3(grid), dim3(512), args, LDS_BYTES, stream);
    if (e != hipSuccess) fprintf(stderr, "cooperative launch failed: %s (grid %d)\n", hipGetErrorString(e), grid);
}
```

```cpp
#include <hip/hip_runtime.h>
#include <hip/hip_cooperative_groups.h>
#include <cstdio>
namespace cg = cooperative_groups;

#define LAS __attribute__((address_space(3)))
typedef unsigned short bf16_t;
typedef short bf16x8 __attribute__((ext_vector_type(8)));
typedef short bf16x4 __attribute__((ext_vector_type(4)));
typedef float f32x4 __attribute__((ext_vector_type(4)));
typedef unsigned u32x4 __attribute__((ext_vector_type(4)));
typedef unsigned u32x2 __attribute__((ext_vector_type(2)));

constexpr int DM = 2048, MP = 8192, MS = 128, MR = 8320, MT = 8448, SEQ = 2048;
constexpr int NQ = 9216;
constexpr int NG = 4096;
constexpr int NWIN = 13568;
constexpr int DFF = 5632;
constexpr int IN_COLS = 13344;
constexpr float EPS = 1e-6f;

constexpr int SWD = 132, SKT = 68;
constexpr int IMG_WD = 0, IMG_QD = 8448, IMG_KT = 16896, IMG_QK = 25600, IMG_ELEMS = 30208, IMG_BYTES = 60416, IMG_PIECES = 59;

constexpr size_t SZ_WPOOL = 4ull * 256 * 256 * 2, SZ_WPU = 2048ull * 1024 * 2, SZ_W2K = 2048ull * 2048 * 2;
constexpr size_t SZ_WGATE = 11264ull * 2048 * 2, SZ_WDOWN = 2048ull * 5632 * 2, SZ_WPLE = 2048ull * 256 * 2;
constexpr size_t SZ_ACT2K = (size_t)MT * 2048 * 2, SZ_F2K = (size_t)MT * 2048 * 4;
constexpr size_t WS_WPOOL = 0;
constexpr size_t WS_WPU = WS_WPOOL + SZ_WPOOL;
constexpr size_t WS_WGU = WS_WPU + SZ_WPU;
constexpr size_t WS_WO = WS_WGU + SZ_W2K;
constexpr size_t WS_WGATE = WS_WO + SZ_W2K;
constexpr size_t WS_WDOWN = WS_WGATE + SZ_WGATE;
constexpr size_t WS_WPLE = WS_WDOWN + SZ_WDOWN;
constexpr size_t WS_WPLEG = WS_WPLE + SZ_WPLE;
constexpr size_t WS_PBF = WS_WPLEG + SZ_W2K;
constexpr size_t WS_GB = WS_PBF + (size_t)MT * 256 * 2;
constexpr size_t WS_GL = WS_GB + (size_t)MT * 32 * 4;
constexpr size_t WS_B = WS_GL + 8192;
constexpr size_t SZ_B = (size_t)MT * 1024 * 2 * 2 + SZ_ACT2K;
constexpr size_t WS_WIN = WS_B;
constexpr size_t WS_D = WS_B, WS_POOLOUT = WS_D + (size_t)MT * 1024 * 2, WS_GDNOUT = WS_POOLOUT + (size_t)MT * 1024 * 2;
constexpr size_t WS_X2B = WS_GDNOUT;
constexpr size_t WS_PROJ = WS_B + SZ_B;
constexpr size_t SZ_PROJ = (size_t)MT * NQ * 2;
constexpr size_t WS_T1 = WS_PROJ, WS_MERGED = WS_T1 + SZ_F2K, WS_ACT = WS_PROJ;
constexpr size_t WS_GATES = WS_PROJ + SZ_PROJ;
constexpr size_t SZ_GATES = (size_t)MT * NG * 2;
constexpr size_t WS_T2 = WS_GATES;
constexpr size_t WS_CHUNK = WS_GATES + SZ_GATES;
constexpr size_t SZ_CHUNK = 2048ull * IMG_BYTES;
constexpr size_t WS_H = WS_CHUNK, WS_X1 = WS_CHUNK, WS_H2 = WS_X1 + SZ_F2K;
constexpr size_t WS_BAR = WS_CHUNK + SZ_CHUNK;
constexpr size_t WS_END = WS_BAR + 16384;
static_assert(SZ_F2K + SZ_ACT2K <= SZ_CHUNK, "X1+H2 fit");
static_assert(SZ_F2K + SZ_ACT2K <= SZ_PROJ && (size_t)MT * DFF * 2 <= SZ_PROJ, "T1+MERGED / ACT fit");
static_assert((size_t)NWIN * 2048 * 2 <= SZ_B, "WIN fits");

constexpr size_t O_YP = 0, O_YS = 16777216, O_POOLP = O_YS + 262144, O_CONVP = O_POOLP + 61440, O_SSMP = O_CONVP + 73728;
constexpr size_t O_POOLS = O_SSMP + 1048576, O_CONVS = O_POOLS + 1966080, O_SSMS = O_CONVS + 2359296;

constexpr int LDS_BYTES = 147456;

struct Params {
    const float* in[24];
    float* out;
    unsigned char* ws;
    int ph_lo, ph_hi;
};

typedef __bf16 bf16x2_t __attribute__((ext_vector_type(2)));
typedef float f32x2_t __attribute__((ext_vector_type(2)));
__device__ __forceinline__ unsigned pk2(float lo, float hi) { const f32x2_t v = {lo, hi}; const bf16x2_t b = __builtin_convertvector(v, bf16x2_t); return __builtin_bit_cast(unsigned, b); }
__device__ __forceinline__ bf16_t f2bf(float x) { return (bf16_t)(pk2(x, 0.f) & 0xffffu); }
__device__ __forceinline__ float bf2f(bf16_t b) { return __uint_as_float(((unsigned)b) << 16); }
__device__ __forceinline__ float bflo(unsigned w) { return __uint_as_float(w << 16); }
__device__ __forceinline__ float bfhi(unsigned w) { return __uint_as_float(w & 0xffff0000u); }
__device__ __forceinline__ float sigmoidf_(float x) { return __builtin_amdgcn_rcpf(1.0f + __expf(-x)); }
__device__ __forceinline__ float siluf_(float x) { return x * __builtin_amdgcn_rcpf(1.0f + __expf(-x)); }
__device__ __forceinline__ float wave_sum(float v) {
#pragma unroll
    for (int o = 1; o < 64; o <<= 1) v += __shfl_xor(v, o);
    return v;
}
__device__ __forceinline__ float bperm(float v, int srclane) { return __builtin_bit_cast(float, __builtin_amdgcn_ds_bpermute(srclane << 2, __builtin_bit_cast(int, v))); }
#define BAR_LDS() do { asm volatile("s_waitcnt lgkmcnt(0)" ::: "memory"); __builtin_amdgcn_s_barrier(); asm volatile("" ::: "memory"); } while (0)
__device__ __forceinline__ float dpp_sum16(float v) {
    v += __builtin_bit_cast(float, __builtin_amdgcn_update_dpp(0, __builtin_bit_cast(int, v), 0xB1, 0xF, 0xF, true));
    v += __builtin_bit_cast(float, __builtin_amdgcn_update_dpp(0, __builtin_bit_cast(int, v), 0x4E, 0xF, 0xF, true));
    v += __builtin_bit_cast(float, __builtin_amdgcn_update_dpp(0, __builtin_bit_cast(int, v), 0x141, 0xF, 0xF, true));
    v += __builtin_bit_cast(float, __builtin_amdgcn_update_dpp(0, __builtin_bit_cast(int, v), 0x140, 0xF, 0xF, true));
    return v;
}
#define LDS_WAIT() asm volatile("s_waitcnt lgkmcnt(0)" ::: "memory")
__device__ __forceinline__ int opaque_tid(int wave_s) { unsigned z; asm volatile("s_mov_b32 %0, 0" : "=s"(z));
    const int l = __builtin_amdgcn_mbcnt_hi(~0u, __builtin_amdgcn_mbcnt_lo(~0u, z)); int t = (wave_s << 6) | l; asm volatile("" : "+v"(t)); return t; }

namespace pg8 {
constexpr int BM = 256, BK = 64, HALF = 128, HTB = HALF * BK * 2, NXCD = 8, WGM = 8;
__device__ __forceinline__ int lds_byte(int r, int c) { const int st = (r >> 4) * 2 + (c >> 5), rr = r & 15, cc = c & 31, ob = rr * 64 + cc * 2; return st * 1024 + (ob ^ (((ob >> 9) & 1) << 5)); }
__device__ __forceinline__ void stage_rc(int b, int& R, int& C) { const int st = b / 1024, sb = b % 1024, swz = sb ^ (((sb >> 9) & 1) << 5); R = (st >> 1) * 16 + swz / 64; C = (st & 1) * 32 + (swz % 64) / 2; }
__device__ __forceinline__ int perm32(int rho) { const int n = rho >> 4, i = rho & 15; return 8 * (i >> 2) + 4 * n + (i & 3); }

struct Unit { int pm, pn; };
struct Gemm { const bf16_t* A; const bf16_t* Bt; int lda, ldb, K, nM, nN; long a_pn_off; };

struct StaticOrder {
    int nM, nN, nwg, G, c;
    __device__ void init(int nM_, int nN_, int G_, int c_) { nM = nM_; nN = nN_; nwg = nM * nN; G = G_; c = c_; }
    __device__ bool next(int i, Unit& u) const {
        const long L = (long)i * G + c; if (L >= nwg) return false;
        int wgid = (int)L; { const int q = nwg / NXCD, r = nwg % NXCD, xcd = wgid % NXCD, off = wgid / NXCD; wgid = (xcd < r ? xcd * (q + 1) : r * (q + 1) + (xcd - r) * q) + off; }
        const int nig = WGM * nN, gid = wgid / nig, fm = gid * WGM, gsz = (nM - fm) < WGM ? (nM - fm) : WGM;
        u.pm = fm + ((wgid % nig) % gsz); u.pn = (wgid % nig) / gsz; return true;
    }
};

template <class Epi>
__device__ __forceinline__ void gemm_phase(LAS unsigned char* lds, const Gemm g, const StaticOrder& S, const Epi& E, int wave_s) {
    const int tid = opaque_tid(wave_s), wid = __builtin_amdgcn_readfirstlane(tid >> 6), lane = tid & 63, wr = wid >> 2, wc = wid & 3, fr = lane & 15, fq = lane >> 4;
    const int K = g.K, nt = K / BK;
    unsigned voffA[2], voffB[2];
#pragma unroll
    for (int i = 0; i < 2; ++i) { int R, C; stage_rc(tid * 16 + i * 8192, R, C); const int Rb = (R & ~31) + perm32(R & 31);
        voffA[i] = (unsigned)(R * g.lda + C) * 2u; voffB[i] = (unsigned)(Rb * g.ldb + C) * 2u; }
    const size_t kstep = (size_t)(BK * 2);
    const size_t hstepA = (size_t)HALF * g.lda * 2, hstepB = (size_t)HALF * g.ldb * 2;
    const size_t tstepA = 2 * hstepA, tstepB = 2 * hstepB;
    const unsigned ldsw = (unsigned)wid * 1024u;
    const int aoff = lds_byte(wr * 64 + fr, fq * 8), boff = lds_byte(wc * 32 + fr, fq * 8);
#define PG8_SA(b, h) (((b) * 2 + (h)) * HTB)
#define PG8_SB(b, h) ((4 + (b) * 2 + (h)) * HTB)
#define PG8_STAGE(bufoff, gbase, voff) do { _Pragma("unroll") for (int _i = 0; _i < 2; ++_i) \
        __builtin_amdgcn_global_load_lds((const unsigned*)((const char*)(gbase) + (voff)[_i]), (LAS unsigned*)(lds + (bufoff) + ldsw + _i * 8192), 16, 0, 0); } while (0)
#define PG8_LDA(dst, b, h) do { _Pragma("unroll") for (int m = 0; m < 4; ++m) _Pragma("unroll") for (int k = 0; k < 2; ++k) dst[m][k] = *(const LAS bf16x8*)(lds + PG8_SA(b, h) + aoff + m * 2048 + k * 1024); } while (0)
#define PG8_LDB(dst, b, h) do { _Pragma("unroll") for (int n = 0; n < 2; ++n) _Pragma("unroll") for (int k = 0; k < 2; ++k) dst[n][k] = *(const LAS bf16x8*)(lds + PG8_SB(b, h) + boff + n * 2048 + k * 1024); } while (0)
#define PG8_MMA(ai, bj, At, Bt) do { __builtin_amdgcn_s_setprio(1); _Pragma("unroll") for (int m = 0; m < 4; ++m) _Pragma("unroll") for (int n = 0; n < 2; ++n) _Pragma("unroll") for (int k = 0; k < 2; ++k) \
        acc[ai][bj][m][n] = __builtin_amdgcn_mfma_f32_16x16x32_bf16(Bt[n][k], At[m][k], acc[ai][bj][m][n], 0, 0, 0); __builtin_amdgcn_s_setprio(0); } while (0)
#define PG8_WAIT_V(n) asm volatile("s_waitcnt vmcnt(" #n ")" ::: "memory")
#define PG8_WAIT_L(n) asm volatile("s_waitcnt lgkmcnt(" #n ")" ::: "memory")
#define PG8_BAR __builtin_amdgcn_s_barrier()
#define PG8_SCHED __builtin_amdgcn_sched_barrier(0)
    Unit cur, nxt; int ui = 0;
    if (!S.next(0, cur)) return;
    f32x4 acc[2][2][4][2];
#pragma unroll
    for (int a = 0; a < 2; ++a)
#pragma unroll
        for (int b = 0; b < 2; ++b)
#pragma unroll
            for (int m = 0; m < 4; ++m)
#pragma unroll
                for (int n = 0; n < 2; ++n) acc[a][b][m][n] = (f32x4){0.f, 0.f, 0.f, 0.f};
    bf16x8 At[4][2], B0[2][2], B1[2][2];
    const char* cA = (const char*)g.A + (size_t)cur.pm * tstepA + (size_t)cur.pn * g.a_pn_off * 2; const char* cB = (const char*)g.Bt + (size_t)cur.pn * tstepB;
    PG8_STAGE(PG8_SB(0, 0), cB, voffB); PG8_STAGE(PG8_SB(0, 1), cB + hstepB, voffB); PG8_STAGE(PG8_SA(0, 0), cA, voffA); PG8_STAGE(PG8_SA(0, 1), cA + hstepA, voffA);
    if (wr == 1) PG8_BAR;
    PG8_WAIT_V(2); PG8_BAR;
    PG8_STAGE(PG8_SB(1, 0), cB + kstep, voffB); PG8_STAGE(PG8_SA(1, 0), cA + kstep, voffA); PG8_STAGE(PG8_SB(1, 1), cB + hstepB + kstep, voffB);
    PG8_WAIT_V(6); PG8_BAR;
    for (;;) {
        const bool has_next = S.next(ui + 1, nxt);
        const char* nA = has_next ? (const char*)g.A + (size_t)nxt.pm * tstepA + (size_t)nxt.pn * g.a_pn_off * 2 : cA; const char* nB = has_next ? (const char*)g.Bt + (size_t)nxt.pn * tstepB : cB;
        for (int t = 0; t < nt; t += 2) {
            const bool last = (t == nt - 2);
            const char* a1 = cA + (size_t)(t + 1) * kstep;
            const char* a2 = last ? nA : cA + (size_t)(t + 2) * kstep; const char* b2 = last ? nB : cB + (size_t)(t + 2) * kstep;
            const char* a3 = a2 + kstep; const char* b3 = b2 + kstep;
            PG8_LDB(B0, 0, 0); PG8_LDB(B1, 0, 1); PG8_SCHED; PG8_LDA(At, 0, 0); PG8_STAGE(PG8_SA(1, 1), a1 + hstepA, voffA);
            PG8_WAIT_V(8); PG8_WAIT_L(0); PG8_BAR; PG8_MMA(0, 0, At, B0); PG8_MMA(0, 1, At, B1); PG8_BAR; PG8_SCHED;
            PG8_LDA(At, 0, 1); PG8_STAGE(PG8_SB(0, 0), b2, voffB); PG8_STAGE(PG8_SB(0, 1), b2 + hstepB, voffB); PG8_STAGE(PG8_SA(0, 0), a2, voffA);
            PG8_WAIT_V(8); PG8_WAIT_L(0); PG8_BAR; PG8_MMA(1, 0, At, B0); PG8_MMA(1, 1, At, B1); PG8_BAR; PG8_SCHED;
            PG8_LDB(B0, 1, 0); PG8_LDB(B1, 1, 1); PG8_SCHED; PG8_LDA(At, 1, 0); PG8_STAGE(PG8_SA(0, 1), a2 + hstepA, voffA);
            PG8_WAIT_V(8); PG8_WAIT_L(0); PG8_BAR; PG8_MMA(0, 0, At, B0); PG8_MMA(0, 1, At, B1); PG8_BAR; PG8_SCHED;
            PG8_LDA(At, 1, 1); PG8_STAGE(PG8_SB(1, 0), b3, voffB); PG8_STAGE(PG8_SB(1, 1), b3 + hstepB, voffB); PG8_STAGE(PG8_SA(1, 0), a3, voffA);
            PG8_WAIT_V(8); PG8_WAIT_L(0); PG8_BAR; PG8_MMA(1, 0, At, B0); PG8_MMA(1, 1, At, B1); PG8_BAR; PG8_SCHED;
        }
        if (wr == 0) PG8_BAR;
        E(acc, cur, wr, wc, fr, fq);
        if (!has_next) break;
#pragma unroll
        for (int a = 0; a < 2; ++a)
#pragma unroll
            for (int b = 0; b < 2; ++b)
#pragma unroll
                for (int m = 0; m < 4; ++m)
#pragma unroll
                    for (int n = 0; n < 2; ++n) acc[a][b][m][n] = (f32x4){0.f, 0.f, 0.f, 0.f};
        cur = nxt; cA = nA; cB = nB; ++ui;
        if (wr == 1) PG8_BAR;
    }
    PG8_WAIT_V(0);
    PG8_BAR;
#undef PG8_SA
#undef PG8_SB
#undef PG8_STAGE
#undef PG8_LDA
#undef PG8_LDB
#undef PG8_MMA
#undef PG8_WAIT_V
#undef PG8_WAIT_L
#undef PG8_BAR
#undef PG8_SCHED
}
}
using pg8::Unit;

#define EPI_ARGS const f32x4 (&acc)[2][2][4][2], const Unit& u, int wr, int wc, int fr, int fq
#define EPI_ROW(ai, m) (u.pm * 256 + (ai) * 128 + wr * 64 + (m) * 16 + fr)
#define EPI_COL0 (u.pn * 256 + wc * 32 + fq * 8)
#define EPI_FENCE asm volatile("" ::: "memory")

__device__ __forceinline__ u32x4 pack8(f32x4 v0, f32x4 v1) { u32x4 w; w.x = pk2(v0[0], v0[1]); w.y = pk2(v0[2], v0[3]); w.z = pk2(v1[0], v1[1]); w.w = pk2(v1[2], v1[3]); return w; }

struct EpiProj {
    bf16_t* proj; bf16_t* gates; float* gb; const float* a_log; const float* dt_bias; float* out;
    __device__ __forceinline__ void operator()(EPI_ARGS) const {
        const int col0 = EPI_COL0;
        if (u.pn < 36) {
#pragma unroll
            for (int ai = 0; ai < 2; ++ai)
#pragma unroll
                for (int m = 0; m < 4; ++m) { const int r = EPI_ROW(ai, m); bf16_t* rowp = proj + (size_t)r * NQ + col0;
#pragma unroll
                    for (int bj = 0; bj < 2; ++bj) *(u32x4*)(rowp + bj * 128) = pack8(acc[ai][bj][m][0], acc[ai][bj][m][1]); }
            if (u.pn < 28) {
                const bool tailpm = ((u.pm & 7) == 7) && (u.pm < 32), samp = (u.pm == 32);
                if (tailpm || samp) {
#pragma unroll
                    for (int ai = 0; ai < 2; ++ai)
#pragma unroll
                        for (int m = 0; m < 4; ++m) { const int r = EPI_ROW(ai, m); float* dst = nullptr;
                            if (tailpm) { const int t = r & 2047, b = r >> 11;
                                if (u.pn < 4) { if (t >= 2033) dst = out + O_POOLP + ((size_t)(b * 15 + (t - 2033)) * 1024 + col0); }
                                else { if (t >= 2045) dst = out + O_CONVP + ((size_t)(b * 3 + (t - 2045)) * 6144 + (col0 - 1024)); } }
                            else { const int s = r - MP; if (s < MS) { if (u.pn < 4) dst = out + O_POOLS + ((size_t)(s * 15 + 14) * 1024 + col0); else dst = out + O_CONVS + ((size_t)(s * 3 + 2) * 6144 + (col0 - 1024)); } }
                            if (dst) {
#pragma unroll
                                for (int bj = 0; bj < 2; ++bj) { *(f32x4*)(dst + bj * 128) = acc[ai][bj][m][0]; *(f32x4*)(dst + bj * 128 + 4) = acc[ai][bj][m][1]; } } }
                }
            }
        } else if (u.pn < 52) {
            const int gc0 = col0 - 36 * 256;
#pragma unroll
            for (int ai = 0; ai < 2; ++ai)
#pragma unroll
                for (int m = 0; m < 4; ++m) { const int r = EPI_ROW(ai, m); bf16_t* rowp = gates + (size_t)r * NG + gc0;
#pragma unroll
                    for (int bj = 0; bj < 2; ++bj) { f32x4 v0 = acc[ai][bj][m][0], v1 = acc[ai][bj][m][1];
#pragma unroll
                        for (int j = 0; j < 4; ++j) { v0[j] = sigmoidf_(v0[j]); v1[j] = sigmoidf_(v1[j]); }
                        *(u32x4*)(rowp + bj * 128) = pack8(v0, v1); } }
        } else {
            if (wc == 0) {
                const int c0 = fq * 8;
                float al[8], db[8];
#pragma unroll
                for (int j = 0; j < 8; ++j) { const int h = (c0 + j) & 15; al[j] = -__expf(a_log[h]); db[j] = dt_bias[h]; }
#pragma unroll
                for (int ai = 0; ai < 2; ++ai)
#pragma unroll
                    for (int m = 0; m < 4; ++m) { const int r = EPI_ROW(ai, m); float v[8];
#pragma unroll
                        for (int j = 0; j < 4; ++j) { v[j] = acc[ai][0][m][0][j]; v[4 + j] = acc[ai][0][m][1][j]; }
#pragma unroll
                        for (int j = 0; j < 8; ++j) {
                            if (fq < 2) { const float x = v[j] + db[j]; const float sp = (x > 20.f) ? x : log1pf(__expf(x)); v[j] = al[j] * sp; }
                            else v[j] = sigmoidf_(v[j]); }
                        float* dst = gb + (size_t)r * 32 + c0;
                        *(f32x4*)dst = (f32x4){v[0], v[1], v[2], v[3]}; *(f32x4*)(dst + 4) = (f32x4){v[4], v[5], v[6], v[7]}; }
            }
        }
    }
};
struct EpiPoolGrp {
    bf16_t* o; const float* scale;
    __device__ __forceinline__ void operator()(EPI_ARGS) const {
        const int col0 = EPI_COL0;
#pragma unroll
        for (int ai = 0; ai < 2; ++ai)
#pragma unroll
            for (int m = 0; m < 4; ++m) { const int r = EPI_ROW(ai, m); bf16_t* rowp = o + (size_t)r * 1024 + col0;
#pragma unroll
                for (int bj = 0; bj < 2; ++bj) { const f32x4 sc0 = *(const f32x4*)(scale + col0 + bj * 128), sc1 = *(const f32x4*)(scale + col0 + bj * 128 + 4);
                    *(u32x4*)(rowp + bj * 128) = pack8(acc[ai][bj][m][0] * sc0, acc[ai][bj][m][1] * sc1); }
                EPI_FENCE; }
    }
};
struct EpiPoolUp {
    bf16_t* t1; const bf16_t* gates;
    __device__ __forceinline__ void operator()(EPI_ARGS) const {
        const int col0 = EPI_COL0;
#pragma unroll
        for (int ai = 0; ai < 2; ++ai)
#pragma unroll
            for (int m = 0; m < 4; ++m) { const int r = EPI_ROW(ai, m); bf16_t* rowp = t1 + (size_t)r * DM + col0; const bf16_t* gp = gates + (size_t)r * NG + col0;
#pragma unroll
                for (int bj = 0; bj < 2; ++bj) { const u32x4 gw = *(const u32x4*)(gp + bj * 128);
                    f32x4 g0 = (f32x4){bflo(gw.x), bfhi(gw.x), bflo(gw.y), bfhi(gw.y)}, g1 = (f32x4){bflo(gw.z), bfhi(gw.z), bflo(gw.w), bfhi(gw.w)};
                    *(u32x4*)(rowp + bj * 128) = pack8(acc[ai][bj][m][0] * g0, acc[ai][bj][m][1] * g1); }
                if (m == 3) EPI_FENCE; }
    }
};
struct EpiMerge {
    const bf16_t* t1; const bf16_t* gates; bf16_t* merged;
    __device__ __forceinline__ void operator()(EPI_ARGS) const {
        const int col0 = EPI_COL0;
#pragma unroll
        for (int ai = 0; ai < 2; ++ai)
#pragma unroll
            for (int m = 0; m < 4; ++m) { const int r = EPI_ROW(ai, m); const bf16_t* tp = t1 + (size_t)r * DM + col0; const bf16_t* gp = gates + (size_t)r * NG + 2048 + col0; bf16_t* op = merged + (size_t)r * DM + col0;
#pragma unroll
                for (int bj = 0; bj < 2; ++bj) { const u32x4 gw = *(const u32x4*)(gp + bj * 128), tw = *(const u32x4*)(tp + bj * 128);
                    f32x4 g0 = (f32x4){bflo(gw.x), bfhi(gw.x), bflo(gw.y), bfhi(gw.y)}, g1 = (f32x4){bflo(gw.z), bfhi(gw.z), bflo(gw.w), bfhi(gw.w)};
                    const f32x4 a0 = (f32x4){bflo(tw.x), bfhi(tw.x), bflo(tw.y), bfhi(tw.y)}, a1 = (f32x4){bflo(tw.z), bfhi(tw.z), bflo(tw.w), bfhi(tw.w)};
                    *(u32x4*)(op + bj * 128) = pack8(a0 + acc[ai][bj][m][0] * g0, a1 + acc[ai][bj][m][1] * g1); }
                if (m == 3) EPI_FENCE; }
    }
};
struct EpiWo {
    const float* xp; const float* xs; bf16_t* x1b;
    __device__ __forceinline__ void operator()(EPI_ARGS) const {
        const int col0 = EPI_COL0;
#pragma unroll
        for (int ai = 0; ai < 2; ++ai)
#pragma unroll
            for (int m = 0; m < 4; ++m) { const int r = EPI_ROW(ai, m); bf16_t* op = x1b + (size_t)r * DM + col0;
                const float* xr = (r < MP) ? xp + (size_t)r * DM + col0 : xs + (size_t)((r < MR ? r : MP) - MP) * DM + col0;
#pragma unroll
                for (int bj = 0; bj < 2; ++bj) { const f32x4 a0 = __builtin_nontemporal_load((const f32x4*)(xr + bj * 128)), a1 = __builtin_nontemporal_load((const f32x4*)(xr + bj * 128 + 4));
                    *(u32x4*)(op + bj * 128) = pack8(a0 + acc[ai][bj][m][0], a1 + acc[ai][bj][m][1]); }
                if (m == 3) EPI_FENCE; }
    }
};
struct EpiGateUp {
    bf16_t* act;
    __device__ __forceinline__ void operator()(EPI_ARGS) const {
        const int col0 = u.pn * 128 + wc * 32 + fq * 8;
#pragma unroll
        for (int ai = 0; ai < 2; ++ai)
#pragma unroll
            for (int m = 0; m < 4; ++m) { const int r = EPI_ROW(ai, m); f32x4 v0, v1;
#pragma unroll
                for (int j = 0; j < 4; ++j) { v0[j] = siluf_(acc[ai][0][m][0][j]) * acc[ai][1][m][0][j]; v1[j] = siluf_(acc[ai][0][m][1][j]) * acc[ai][1][m][1][j]; }
                *(u32x4*)(act + (size_t)r * DFF + col0) = pack8(v0, v1); }
    }
};
struct EpiDown {
    const bf16_t* x1b; bf16_t* x2b;
    __device__ __forceinline__ void operator()(EPI_ARGS) const {
        const int col0 = EPI_COL0;
#pragma unroll
        for (int ai = 0; ai < 2; ++ai)
#pragma unroll
            for (int m = 0; m < 4; ++m) { const int r = EPI_ROW(ai, m); const bf16_t* op = x1b + (size_t)r * DM + col0; bf16_t* bp = x2b + (size_t)r * DM + col0;
#pragma unroll
                for (int bj = 0; bj < 2; ++bj) { const u32x4 xw = *(const u32x4*)(op + bj * 128);
                    const f32x4 a0 = (f32x4){bflo(xw.x), bfhi(xw.x), bflo(xw.y), bfhi(xw.y)}, a1 = (f32x4){bflo(xw.z), bfhi(xw.z), bflo(xw.w), bfhi(xw.w)};
                    *(u32x4*)(bp + bj * 128) = pack8(a0 + acc[ai][bj][m][0], a1 + acc[ai][bj][m][1]); }
                if (m == 3) EPI_FENCE; }
    }
};
struct EpiPle {
    bf16_t* t2;
    __device__ __forceinline__ void operator()(EPI_ARGS) const {
        const int col0 = EPI_COL0;
#pragma unroll
        for (int ai = 0; ai < 2; ++ai)
#pragma unroll
            for (int m = 0; m < 4; ++m) { const int r = EPI_ROW(ai, m); bf16_t* op = t2 + (size_t)r * DM + col0;
#pragma unroll
                for (int bj = 0; bj < 2; ++bj) *(u32x4*)(op + bj * 128) = pack8(acc[ai][bj][m][0], acc[ai][bj][m][1]);
                EPI_FENCE; }
    }
};
struct EpiPleGate {
    bf16_t* x3; const bf16_t* x2b; const bf16_t* t2;
    __device__ __forceinline__ void operator()(EPI_ARGS) const {
        const int col0 = EPI_COL0;
#pragma unroll
        for (int ai = 0; ai < 2; ++ai)
#pragma unroll
            for (int m = 0; m < 4; ++m) { const int r = EPI_ROW(ai, m); bf16_t* op = x3 + (size_t)r * DM + col0; const bf16_t* xp = x2b + (size_t)r * DM + col0; const bf16_t* tp = t2 + (size_t)r * DM + col0;
#pragma unroll
                for (int bj = 0; bj < 2; ++bj) { const u32x4 xw = *(const u32x4*)(xp + bj * 128), tw = *(const u32x4*)(tp + bj * 128);
                    f32x4 a0 = (f32x4){bflo(xw.x), bfhi(xw.x), bflo(xw.y), bfhi(xw.y)}, a1 = (f32x4){bflo(xw.z), bfhi(xw.z), bflo(xw.w), bfhi(xw.w)};
                    const f32x4 p0 = (f32x4){bflo(tw.x), bfhi(tw.x), bflo(tw.y), bfhi(tw.y)}, p1 = (f32x4){bflo(tw.z), bfhi(tw.z), bflo(tw.w), bfhi(tw.w)};
#pragma unroll
                    for (int j = 0; j < 4; ++j) { a0[j] += p0[j] * sigmoidf_(acc[ai][bj][m][0][j]); a1[j] += p1[j] * sigmoidf_(acc[ai][bj][m][1][j]); }
                    *(u32x4*)(op + bj * 128) = pack8(a0, a1); }
                if (m == 3) EPI_FENCE; }
    }
};

__device__ __forceinline__ void transpose_item(const float* W, int N, int K, bf16_t* WT, int k0, int n0src, int n0dst, LAS float* scr, int lane) {
    float tv[32];
#pragma unroll
    for (int i = 0; i < 32; ++i) tv[i] = __builtin_nontemporal_load(&W[(size_t)(k0 + 2 * i + (lane >> 5)) * N + n0src + (lane & 31)]);
#pragma unroll
    for (int i = 0; i < 32; ++i) scr[(2 * i + (lane >> 5)) * 33 + (lane & 31)] = tv[i];
    LDS_WAIT();
    const int c = lane & 7;
#pragma unroll
    for (int j = 0; j < 4; ++j) { const int n = (lane >> 3) + 8 * j; const LAS float* s = scr + (8 * c) * 33 + n;
        u32x4 o; o.x = pk2(s[0 * 33], s[1 * 33]); o.y = pk2(s[2 * 33], s[3 * 33]); o.z = pk2(s[4 * 33], s[5 * 33]); o.w = pk2(s[6 * 33], s[7 * 33]);
        *(u32x4*)(WT + (size_t)(n0dst + n) * K + k0 + 8 * c) = o; }
    LDS_WAIT();
}
constexpr int CV_WIN = 32 * 417, CV_POOL = 4 * 4 * 8, CV_WPU = 16 * 64, CV_2K = 32 * 64, CV_GATE = 32 * 352, CV_DOWN = 88 * 64, CV_PLE = 4 * 64;
constexpr int CV_SPLIT = CV_WIN + CV_POOL + CV_WPU + 2 * CV_2K + CV_GATE, CV_END = CV_SPLIT + CV_2K + CV_DOWN + CV_PLE;
__device__ __forceinline__ void convert_items(const Params& p, LAS float* scr, int lane, int gw, int NGW, int it_lo, int it_hi) {
    unsigned char* ws = p.ws;
    for (int it = it_lo + gw; it < it_hi; it += NGW) {
        int r = it;
        if (r < CV_WIN) { const int kb = r / 417, nb = r % 417, ns = nb * 32; const int nd = ns < 9216 ? ns : (ns < 9248 ? 13312 + (ns - 9216) : ns - 32);
            transpose_item(p.in[8], IN_COLS, 2048, (bf16_t*)(ws + WS_WIN), kb * 64, ns, nd, scr, lane); continue; } r -= CV_WIN;
        if (r < CV_POOL) { const int g = r / 32, q = r % 32, kb = q / 8, nb = q % 8;
            transpose_item(p.in[9] + g * 65536, 256, 256, (bf16_t*)(ws + WS_WPOOL) + g * 65536, kb * 64, nb * 32, nb * 32, scr, lane); continue; } r -= CV_POOL;
        if (r < CV_WPU) { const int kb = r / 64, nb = r % 64; transpose_item(p.in[15], 2048, 1024, (bf16_t*)(ws + WS_WPU), kb * 64, nb * 32, nb * 32, scr, lane); continue; } r -= CV_WPU;
        if (r < CV_2K) { const int kb = r / 64, nb = r % 64; transpose_item(p.in[16], 2048, 2048, (bf16_t*)(ws + WS_WGU), kb * 64, nb * 32, nb * 32, scr, lane); continue; } r -= CV_2K;
        if (r < CV_2K) { const int kb = r / 64, nb = r % 64; transpose_item(p.in[17], 2048, 2048, (bf16_t*)(ws + WS_WO), kb * 64, nb * 32, nb * 32, scr, lane); continue; } r -= CV_2K;
        if (r < CV_GATE) { const int kb = r / 352, nb = r % 352, ns = nb * 32; int nd; if (ns < DFF) nd = 256 * (ns / 128) + (ns % 128); else { const int j = ns - DFF; nd = 256 * (j / 128) + 128 + (j % 128); }
            transpose_item(p.in[19], 2 * DFF, 2048, (bf16_t*)(ws + WS_WGATE), kb * 64, ns, nd, scr, lane); continue; } r -= CV_GATE;
        if (r < CV_2K) { const int kb = r / 64, nb = r % 64; transpose_item(p.in[22], 2048, 2048, (bf16_t*)(ws + WS_WPLEG), kb * 64, nb * 32, nb * 32, scr, lane); continue; } r -= CV_2K;
        if (r < CV_DOWN) { const int kb = r / 64, nb = r % 64; transpose_item(p.in[20], 2048, DFF, (bf16_t*)(ws + WS_WDOWN), kb * 64, nb * 32, nb * 32, scr, lane); continue; } r -= CV_DOWN;
        { const int kb = r / 64, nb = r % 64; transpose_item(p.in[21], 2048, 256, (bf16_t*)(ws + WS_WPLE), kb * 64, nb * 32, nb * 32, scr, lane); }
    }
}
__device__ __forceinline__ void rms_row_bf16(const float* xrow, const float* g, bf16_t* orow, int lane) {
    const f32x4* xr = (const f32x4*)xrow + lane; f32x4 v[8]; float s = 0.f;
#pragma unroll
    for (int j = 0; j < 8; ++j) { v[j] = __builtin_nontemporal_load(xr + 64 * j); s += (v[j].x * v[j].x + v[j].y * v[j].y) + (v[j].z * v[j].z + v[j].w * v[j].w); }
    const float rstd = rsqrtf(wave_sum(s) * (1.f / DM) + EPS);
    const f32x4* gr = (const f32x4*)g + lane; u32x2* o8 = (u32x2*)orow + lane;
#pragma unroll
    for (int j = 0; j < 8; ++j) { const f32x4 gg = gr[64 * j]; u32x2 w; w.x = pk2(v[j].x * rstd * gg.x, v[j].y * rstd * gg.y); w.y = pk2(v[j].z * rstd * gg.z, v[j].w * rstd * gg.w); o8[64 * j] = w; }
}
__device__ __forceinline__ void rms_row_b2b(const bf16_t* xrow, const float* g, bf16_t* orow, int lane) {
    const u32x4* xr = (const u32x4*)xrow + lane; u32x4 w[4]; float s = 0.f;
#pragma unroll
    for (int j = 0; j < 4; ++j) { w[j] = xr[64 * j];
        const float a0 = bflo(w[j].x), a1 = bfhi(w[j].x), a2 = bflo(w[j].y), a3 = bfhi(w[j].y), a4 = bflo(w[j].z), a5 = bfhi(w[j].z), a6 = bflo(w[j].w), a7 = bfhi(w[j].w);
        s += ((a0 * a0 + a1 * a1) + (a2 * a2 + a3 * a3)) + ((a4 * a4 + a5 * a5) + (a6 * a6 + a7 * a7)); }
    const float rstd = rsqrtf(wave_sum(s) * (1.f / DM) + EPS);
    u32x4* o = (u32x4*)orow + lane;
#pragma unroll
    for (int j = 0; j < 4; ++j) { const f32x4 g0 = ((const f32x4*)g)[(64 * j + lane) * 2], g1 = ((const f32x4*)g)[(64 * j + lane) * 2 + 1]; u32x4 r;
        r.x = pk2(bflo(w[j].x) * rstd * g0.x, bfhi(w[j].x) * rstd * g0.y); r.y = pk2(bflo(w[j].y) * rstd * g0.z, bfhi(w[j].y) * rstd * g0.w);
        r.z = pk2(bflo(w[j].z) * rstd * g1.x, bfhi(w[j].z) * rstd * g1.y); r.w = pk2(bflo(w[j].w) * rstd * g1.z, bfhi(w[j].w) * rstd * g1.w); o[64 * j] = r; }
}
__device__ __forceinline__ void rms_row_b2f(const bf16_t* xrow, const float* g, float* orow, int lane) {
    const u32x4* xr = (const u32x4*)xrow + lane; u32x4 w[4]; float s = 0.f;
#pragma unroll
    for (int j = 0; j < 4; ++j) { w[j] = xr[64 * j];
        const float a0 = bflo(w[j].x), a1 = bfhi(w[j].x), a2 = bflo(w[j].y), a3 = bfhi(w[j].y), a4 = bflo(w[j].z), a5 = bfhi(w[j].z), a6 = bflo(w[j].w), a7 = bfhi(w[j].w);
        s += ((a0 * a0 + a1 * a1) + (a2 * a2 + a3 * a3)) + ((a4 * a4 + a5 * a5) + (a6 * a6 + a7 * a7)); }
    const float rstd = rsqrtf(wave_sum(s) * (1.f / DM) + EPS);
    f32x4* o = (f32x4*)orow;
#pragma unroll
    for (int j = 0; j < 4; ++j) { const int q = (64 * j + lane) * 2; const f32x4 g0 = ((const f32x4*)g)[q], g1 = ((const f32x4*)g)[q + 1];
        __builtin_nontemporal_store((f32x4){bflo(w[j].x) * rstd * g0.x, bfhi(w[j].x) * rstd * g0.y, bflo(w[j].y) * rstd * g0.z, bfhi(w[j].y) * rstd * g0.w}, o + q);
        __builtin_nontemporal_store((f32x4){bflo(w[j].z) * rstd * g1.x, bfhi(w[j].z) * rstd * g1.y, bflo(w[j].w) * rstd * g1.z, bfhi(w[j].w) * rstd * g1.w}, o + q + 1); }
}
__device__ __forceinline__ void rms_row_f32(const float* xrow, const float* g, float* orow, int lane) {
    const f32x4* xr = (const f32x4*)xrow + lane; f32x4 v[8]; float s = 0.f;
#pragma unroll
    for (int j = 0; j < 8; ++j) { v[j] = xr[64 * j]; s += (v[j].x * v[j].x + v[j].y * v[j].y) + (v[j].z * v[j].z + v[j].w * v[j].w); }
    const float rstd = rsqrtf(wave_sum(s) * (1.f / DM) + EPS);
    const f32x4* gr = (const f32x4*)g + lane; f32x4* o = (f32x4*)orow + lane;
#pragma unroll
    for (int j = 0; j < 8; ++j) { const f32x4 gg = gr[64 * j]; o[64 * j] = (f32x4){v[j].x * rstd * gg.x, v[j].y * rstd * gg.y, v[j].z * rstd * gg.z, v[j].w * rstd * gg.w}; }
}

__device__ __forceinline__ void phase0(const Params& p, LAS unsigned char* lds, int wave_s) {
    const int tid = opaque_tid(wave_s), lane = tid & 63, wave = tid >> 6;
    const int gw = blockIdx.x * 8 + wave, NGW = gridDim.x * 8;
    LAS float* scr = (LAS float*)(lds + wave * 8448);
    unsigned char* ws = p.ws;
    convert_items(p, scr, lane, gw, NGW, 0, CV_SPLIT);
    { u32x4* z = (u32x4*)((bf16_t*)(ws + WS_WIN) + (size_t)13344 * 2048); const int n16 = 224 * 2048 * 2 / 16;
      for (int i = blockIdx.x * 512 + tid; i < n16; i += gridDim.x * 512) z[i] = (u32x4){0u, 0u, 0u, 0u}; }
    bf16_t* H = (bf16_t*)(ws + WS_H);
    for (int m = gw; m < MT; m += NGW) {
        if (m < MR) { const float* xr = (m < MP) ? p.in[0] + (size_t)m * DM : p.in[1] + (size_t)(m - MP) * DM; rms_row_bf16(xr, p.in[7], H + (size_t)m * DM, lane); }
        else { u32x2* o8 = (u32x2*)(H + (size_t)m * DM) + lane;
#pragma unroll
            for (int j = 0; j < 8; ++j) o8[64 * j] = (u32x2){0u, 0u}; }
    }
    bf16_t* PB = (bf16_t*)(ws + WS_PBF);
    for (int m = gw; m < MT; m += NGW) {
        u32x2 w = (u32x2){0u, 0u};
        if (m < MR) { const float* pr = (m < MP) ? p.in[2] + (size_t)m * 256 : p.in[3] + (size_t)(m - MP) * 256; const f32x4 v = __builtin_nontemporal_load((const f32x4*)pr + lane); w.x = pk2(v.x, v.y); w.y = pk2(v.z, v.w); }
        ((u32x2*)(PB + (size_t)m * 256))[lane] = w;
    }
    { const int n4 = MS * 14 * 256;
      for (int i = blockIdx.x * 512 + tid; i < n4; i += gridDim.x * 512) { const int s = i / (14 * 256), q = i % (14 * 256);
          ((f32x4*)(p.out + O_POOLS + (size_t)s * 15 * 1024))[q] = ((const f32x4*)(p.in[4] + (size_t)s * 15 * 1024 + 1024))[q]; }
      const int m4 = MS * 2 * 1536;
      for (int i = blockIdx.x * 512 + tid; i < m4; i += gridDim.x * 512) { const int s = i / (2 * 1536), q = i % (2 * 1536);
          ((f32x4*)(p.out + O_CONVS + (size_t)s * 3 * 6144))[q] = ((const f32x4*)(p.in[5] + (size_t)s * 3 * 6144 + 6144))[q]; } }
}

__device__ __forceinline__ void acc8(float (&sum)[8], const u32x4 v, float mk) {
    sum[0] += bflo(v.x) * mk; sum[1] += bfhi(v.x) * mk; sum[2] += bflo(v.y) * mk; sum[3] += bfhi(v.y) * mk; sum[4] += bflo(v.z) * mk; sum[5] += bfhi(v.z) * mk; sum[6] += bflo(v.w) * mk; sum[7] += bfhi(v.w) * mk;
}
template <int W>
__device__ __forceinline__ void pool_item(const Params& p, const bf16_t* PROJ, bf16_t* D, int r, int c0) {
    float sum[8], uu[8];
    const u32x4 v0 = *(const u32x4*)(PROJ + (size_t)r * NQ + c0);
    uu[0] = bflo(v0.x); uu[1] = bfhi(v0.x); uu[2] = bflo(v0.y); uu[3] = bfhi(v0.y); uu[4] = bflo(v0.z); uu[5] = bfhi(v0.z); uu[6] = bflo(v0.w); uu[7] = bfhi(v0.w);
#pragma unroll
    for (int j = 0; j < 8; ++j) sum[j] = uu[j];
    float cnt;
    if (r < MP) {
        const int t = r & 2047; cnt = (float)((t + 1 < W) ? (t + 1) : W);
        u32x4 v[W - 1];
#pragma unroll
        for (int i = 1; i < W; ++i) v[i - 1] = *(const u32x4*)(PROJ + (size_t)(r - (i <= t ? i : 0)) * NQ + c0);
#pragma unroll
        for (int i = 1; i < W; ++i) acc8(sum, v[i - 1], (i <= t) ? 1.f : 0.f);
    } else {
        const int s = r - MP; cnt = (float)W; const float* sp = p.in[4] + (size_t)s * 15 * 1024 + c0;
        f32x4 a[W - 1], b[W - 1];
#pragma unroll
        for (int i = 0; i < W - 1; ++i) { a[i] = *(const f32x4*)(sp + (size_t)(14 - i) * 1024); b[i] = *(const f32x4*)(sp + (size_t)(14 - i) * 1024 + 4); }
#pragma unroll
        for (int i = 0; i < W - 1; ++i) { sum[0] += a[i].x; sum[1] += a[i].y; sum[2] += a[i].z; sum[3] += a[i].w; sum[4] += b[i].x; sum[5] += b[i].y; sum[6] += b[i].z; sum[7] += b[i].w; }
    }
    const float inv = 1.0f / cnt; u32x4 o;
    o.x = pk2(sum[0] * inv - uu[0], sum[1] * inv - uu[1]); o.y = pk2(sum[2] * inv - uu[2], sum[3] * inv - uu[3]);
    o.z = pk2(sum[4] * inv - uu[4], sum[5] * inv - uu[5]); o.w = pk2(sum[6] * inv - uu[6], sum[7] * inv - uu[7]);
    *(u32x4*)(D + (size_t)r * 1024 + c0) = o;
}
__device__ __forceinline__ void phase_pool_d(const Params& p, int wave_s) {
    const bf16_t* PROJ = (const bf16_t*)(p.ws + WS_PROJ); bf16_t* D = (bf16_t*)(p.ws + WS_D);
    const int total = MR * 32;
    const int tid = opaque_tid(wave_s);
    for (int idx = blockIdx.x * 512 + tid; idx < total; idx += gridDim.x * 512) {
        const int r = idx >> 5, ch = idx & 31;
        pool_item<2>(p, PROJ, D, r, ch * 8);
        pool_item<4>(p, PROJ, D, r, 256 + ch * 8);
        pool_item<8>(p, PROJ, D, r, 512 + ch * 8);
        pool_item<16>(p, PROJ, D, r, 768 + ch * 8);
    }
}

__device__ __forceinline__ void conv16(const bf16_t* PROJ, const LAS float* cw, int rowbase, int t, int pcol, float (&y)[16]) {
    u32x4 a[4], b[4];
#pragma unroll
    for (int i = 0; i < 4; ++i) {
        const int tt = t - 3 + i, tc = tt < 0 ? 0 : tt;
        a[i] = *(const u32x4*)(PROJ + (size_t)(rowbase + tc) * NQ + pcol); b[i] = *(const u32x4*)(PROJ + (size_t)(rowbase + tc) * NQ + pcol + 8);
    }
#pragma unroll
    for (int j = 0; j < 16; ++j) y[j] = 0.f;
#pragma unroll
    for (int i = 0; i < 4; ++i) {
        const float mk = (t - 3 + i) >= 0 ? 1.f : 0.f;
        const f32x4 w0 = *(const LAS f32x4*)(cw + i * 128) * mk, w1 = *(const LAS f32x4*)(cw + i * 128 + 4) * mk, w2 = *(const LAS f32x4*)(cw + i * 128 + 8) * mk, w3 = *(const LAS f32x4*)(cw + i * 128 + 12) * mk;
        y[0] += bflo(a[i].x) * w0.x; y[1] += bfhi(a[i].x) * w0.y; y[2] += bflo(a[i].y) * w0.z; y[3] += bfhi(a[i].y) * w0.w;
        y[4] += bflo(a[i].z) * w1.x; y[5] += bfhi(a[i].z) * w1.y; y[6] += bflo(a[i].w) * w1.z; y[7] += bfhi(a[i].w) * w1.w;
        y[8] += bflo(b[i].x) * w2.x; y[9] += bfhi(b[i].x) * w2.y; y[10] += bflo(b[i].y) * w2.z; y[11] += bfhi(b[i].y) * w2.w;
        y[12] += bflo(b[i].z) * w3.x; y[13] += bfhi(b[i].z) * w3.y; y[14] += bflo(b[i].w) * w3.z; y[15] += bfhi(b[i].w) * w3.w;
    }
#pragma unroll
    for (int j = 0; j < 16; ++j) y[j] = siluf_(y[j]);
}

__device__ __forceinline__ void phase_chunk_prep(const Params& p, LAS unsigned char* lds, int wave_s) {
    const int tid0 = opaque_tid(wave_s);
    const bf16_t* PROJ = (const bf16_t*)(p.ws + WS_PROJ); const float* GB = (const float*)(p.ws + WS_GB);
    LAS bf16_t* KN = (LAS bf16_t*)(lds); LAS bf16_t* QN = (LAS bf16_t*)(lds + 17408);
    LAS float* AM = (LAS float*)(lds + 34816); LAS float* RHS = (LAS float*)(lds + 51200);
    LAS float* sgc = (LAS float*)(lds + 116736); LAS float* sbe = (LAS float*)(lds + 116992);
    LAS float* CW = (LAS float*)(lds + 117248);
    const int Gd = gridDim.x, per = 2048 / Gd; const bool contig = (per * Gd == 2048);
    int cur_h = -1;
    for (int uu = blockIdx.x; uu < 2048; uu += Gd) {
        const int unit = contig ? (int)blockIdx.x * per + (uu / Gd) : uu;
        int tid = tid0; asm volatile("" : "+v"(tid));
        const int lane = tid & 63, wave = tid >> 6, fr = lane & 15, fq = lane >> 4;
        const int b = unit >> 9, h = (unit >> 5) & 15, n = unit & 31;
        if (h != cur_h) { cur_h = h;
            for (int i = tid; i < 1536; i += 512) { const int which = i >> 9, tap = (i >> 7) & 3, dd = i & 127; CW[i] = p.in[11][(size_t)tap * 6144 + which * 2048 + h * 128 + dd]; }
            BAR_LDS(); }
        const int rowbase = b * SEQ, t0 = n * 64;
        bf16_t* img = (bf16_t*)(p.ws + WS_CHUNK) + (size_t)unit * IMG_ELEMS;
        float* U = p.out + O_YP + (size_t)unit * 8192;
        if (wave == 0) { const int r = rowbase + t0 + lane; float gc = GB[(size_t)r * 32 + h]; const float be = GB[(size_t)r * 32 + 16 + h];
#pragma unroll
            for (int o = 1; o < 64; o <<= 1) { const float t = bperm(gc, (lane - o) & 63); if (lane >= o) gc += t; }
            sgc[lane] = gc; sbe[lane] = be; }
        const int r = tid >> 3, seg = tid & 7, t = t0 + r;
        float q[16], k[16], v[16];
        conv16(PROJ, CW + seg * 16, rowbase, t, 1024 + h * 128 + seg * 16, q);
        conv16(PROJ, CW + 512 + seg * 16, rowbase, t, 1024 + 2048 + h * 128 + seg * 16, k);
        conv16(PROJ, CW + 1024 + seg * 16, rowbase, t, 1024 + 4096 + h * 128 + seg * 16, v);
        float sq = 0.f, sk = 0.f;
#pragma unroll
        for (int j = 0; j < 16; ++j) { sq += q[j] * q[j]; sk += k[j] * k[j]; }
#pragma unroll
        for (int o = 1; o < 8; o <<= 1) { sq += bperm(sq, lane ^ o); sk += bperm(sk, lane ^ o); }
        const float rq = rsqrtf(sq + EPS) * 0.08838834764831845f, rk = rsqrtf(sk + EPS);
#pragma unroll
        for (int j = 0; j < 16; ++j) { q[j] *= rq; k[j] *= rk; }
        BAR_LDS();
        const float gc_r = sgc[r], be_r = sbe[r], gc_last = sgc[63];
        const float eg = __expf(gc_r), et = __expf(gc_last - gc_r);
        {
            u32x4 w0, w1;
            w0.x = pk2(k[0], k[1]); w0.y = pk2(k[2], k[3]); w0.z = pk2(k[4], k[5]); w0.w = pk2(k[6], k[7]);
            w1.x = pk2(k[8], k[9]); w1.y = pk2(k[10], k[11]); w1.z = pk2(k[12], k[13]); w1.w = pk2(k[14], k[15]);
            *(LAS u32x4*)(KN + r * 136 + seg * 16) = w0; *(LAS u32x4*)(KN + r * 136 + seg * 16 + 8) = w1;
            w0.x = pk2(q[0], q[1]); w0.y = pk2(q[2], q[3]); w0.z = pk2(q[4], q[5]); w0.w = pk2(q[6], q[7]);
            w1.x = pk2(q[8], q[9]); w1.y = pk2(q[10], q[11]); w1.z = pk2(q[12], q[13]); w1.w = pk2(q[14], q[15]);
            *(LAS u32x4*)(QN + r * 136 + seg * 16) = w0; *(LAS u32x4*)(QN + r * 136 + seg * 16 + 8) = w1;
            w0.x = pk2(q[0] * eg, q[1] * eg); w0.y = pk2(q[2] * eg, q[3] * eg); w0.z = pk2(q[4] * eg, q[5] * eg); w0.w = pk2(q[6] * eg, q[7] * eg);
            w1.x = pk2(q[8] * eg, q[9] * eg); w1.y = pk2(q[10] * eg, q[11] * eg); w1.z = pk2(q[12] * eg, q[13] * eg); w1.w = pk2(q[14] * eg, q[15] * eg);
            { bf16_t* qd = img + IMG_QD + r * SWD + seg * 16;
              *(u32x2*)(qd) = (u32x2){w0.x, w0.y}; *(u32x2*)(qd + 4) = (u32x2){w0.z, w0.w}; *(u32x2*)(qd + 8) = (u32x2){w1.x, w1.y}; *(u32x2*)(qd + 12) = (u32x2){w1.z, w1.w}; }
        }
#pragma unroll
        for (int j = 0; j < 16; ++j) { RHS[r * 256 + seg * 16 + j] = v[j] * be_r; RHS[r * 256 + 128 + seg * 16 + j] = k[j] * be_r * eg; }
#pragma unroll
        for (int j = 0; j < 16; ++j) img[IMG_KT + (seg * 16 + j) * SKT + r] = f2bf(k[j] * et);
        if (tid == 0) ((float*)(p.ws + WS_GL))[unit] = __expf(gc_last);
        BAR_LDS();
        {
            const int m = wave & 3; const LAS bf16_t* Arows = (wave < 4) ? KN : QN;
            bf16x8 af[4];
#pragma unroll
            for (int s = 0; s < 4; ++s) af[s] = *(const LAS bf16x8*)(Arows + (16 * m + fr) * 136 + 32 * s + 8 * fq);
#pragma unroll
            for (int nt = 0; nt < 4; ++nt) {
                f32x4 c = (f32x4){0.f, 0.f, 0.f, 0.f};
#pragma unroll
                for (int s = 0; s < 4; ++s) { const bf16x8 bfr = *(const LAS bf16x8*)(KN + (16 * nt + fr) * 136 + 32 * s + 8 * fq); c = __builtin_amdgcn_mfma_f32_16x16x32_bf16(af[s], bfr, c, 0, 0, 0); }
                const int j = 16 * nt + fr; const float gcj = sgc[j];
#pragma unroll
                for (int rg = 0; rg < 4; ++rg) { const int i = 16 * m + 4 * fq + rg; const float gci = sgc[i];
                    if (wave < 4) { const float a = (i > j) ? sbe[i] * c[rg] * __expf(gci - gcj) : 0.f; AM[i * 64 + j] = a; }
                    else { const float a = (i >= j) ? c[rg] * __expf(gci - gcj) : 0.f; img[IMG_QK + i * SKT + j] = f2bf(a); } }
            }
        }
        BAR_LDS();
        if (tid < 256) {
            const int col = tid; float sol[64];
#pragma unroll
            for (int i = 0; i < 64; ++i) sol[i] = 0.f;
#pragma unroll
            for (int i = 0; i < 64; ++i) {
                float s0 = RHS[i * 256 + col], s1 = 0.f, s2 = 0.f, s3 = 0.f;
#pragma unroll
                for (int j4 = 0; j4 < (i + 3) / 4; ++j4) { const f32x4 a = *(const LAS f32x4*)(AM + i * 64 + 4 * j4);
                    s0 -= a.x * sol[4 * j4]; s1 -= a.y * sol[4 * j4 + 1]; s2 -= a.z * sol[4 * j4 + 2]; s3 -= a.w * sol[4 * j4 + 3]; }
                sol[i] = (s0 + s1) + (s2 + s3);
            }
            if (col < 128) {
#pragma unroll
                for (int mm = 0; mm < 4; ++mm)
#pragma unroll
                    for (int q4 = 0; q4 < 4; ++q4)
                        *(f32x4*)(U + ((((col >> 4) * 4 + mm) * 64 + q4 * 16 + (col & 15)) << 2)) = (f32x4){sol[16 * mm + 4 * q4], sol[16 * mm + 4 * q4 + 1], sol[16 * mm + 4 * q4 + 2], sol[16 * mm + 4 * q4 + 3]};
            } else {
#pragma unroll
                for (int i = 0; i < 64; ++i) img[IMG_WD + i * SWD + (col - 128)] = f2bf(sol[i]);
            }
        }
        BAR_LDS();
    }
    __syncthreads();
}

__device__ __forceinline__ bf16x8 acc2frag(const f32x4 a, const f32x4 b) {
    u32x4 w; w.x = pk2(a[0], a[1]); w.y = pk2(a[2], a[3]); w.z = pk2(b[0], b[1]); w.w = pk2(b[2], b[3]);
    return __builtin_bit_cast(bf16x8, w);
}
__device__ __forceinline__ bf16x8 ldfrag(const LAS bf16_t* p) {
    const u32x2 a = *(const LAS u32x2*)p, b = *(const LAS u32x2*)(p + 16);
    u32x4 w; w.x = a.x; w.y = a.y; w.z = b.x; w.w = b.y; return __builtin_bit_cast(bf16x8, w);
}
__device__ __forceinline__ void phase_scan(const Params& p, LAS unsigned char* lds, int bh, int wave_s) {
    const int tid = opaque_tid(wave_s), lane = tid & 63, wave = __builtin_amdgcn_readfirstlane(tid >> 6), fr = lane & 15, fq = lane >> 4;
    const int b = bh >> 4, h = bh & 15, e0 = wave * 16;
    const bf16_t* PROJ = (const bf16_t*)(p.ws + WS_PROJ); bf16_t* GDN = (bf16_t*)(p.ws + WS_GDNOUT);
    const float* GL = (const float*)(p.ws + WS_GL);
    LAS float* SCR = (LAS float*)(lds + 2 * IMG_BYTES);
    const float gnorm = p.in[14][e0 + fr];
    f32x4 Sacc[8];
#pragma unroll
    for (int m = 0; m < 8; ++m) Sacc[m] = (f32x4){0.f, 0.f, 0.f, 0.f};
    const int unit0 = bh * 32;
    const unsigned char* chunk0 = (const unsigned char*)(p.ws + WS_CHUNK) + (size_t)unit0 * IMG_BYTES;
    const float* U0 = p.out + O_YP + (size_t)unit0 * 8192 + ((wave * 256 + lane) << 2);
    const bf16_t* Z0 = PROJ + ((size_t)b * SEQ + (tid >> 3)) * NQ + 7168 + h * 128 + (tid & 7) * 16;
    LAS bf16_t* ZT = (LAS bf16_t*)(lds + 2 * IMG_BYTES + 4096);
    LAS bf16_t* ztw = ZT + (tid >> 3) * 136 + (tid & 7) * 16;
#define SCAN_COPY(srcbase, bufidx) do { _Pragma("unroll") for (int k = 0; k < 8; ++k) { const int pc = wave + 8 * k; if (pc < IMG_PIECES) \
        __builtin_amdgcn_global_load_lds((const unsigned*)((srcbase) + pc * 1024 + lane * 16), (LAS unsigned*)(lds + (bufidx) * IMG_BYTES + pc * 1024), 16, 0, 2); } } while (0)
#define SCAN_LOAD(n_, uu, z0, z1, gl) do { const float* U_ = U0 + (size_t)(n_) * 8192; const bf16_t* Z_ = Z0 + (size_t)(n_) * 64 * NQ; \
        z0 = *(const u32x4*)Z_; z1 = *(const u32x4*)(Z_ + 8); \
        _Pragma("unroll") for (int mm = 0; mm < 4; ++mm) uu[mm] = *(const f32x4*)(U_ + mm * 256); \
        gl = GL[unit0 + (n_)]; } while (0)
    SCAN_COPY(chunk0, 0);
    f32x4 ucur[4]; float glcur; u32x4 zr0, zr1;
    SCAN_LOAD(0, ucur, zr0, zr1, glcur);
    asm volatile("s_waitcnt vmcnt(0)" ::: "memory");
    *(LAS u32x4*)ztw = zr0; *(LAS u32x4*)(ztw + 8) = zr1;
    BAR_LDS();
    for (int n = 0; n < 32; ++n) {
        const int cur = n & 1;
        const LAS bf16_t* img = (const LAS bf16_t*)(lds + cur * IMG_BYTES);
        const bool hasn = (n + 1 < 32);
        f32x4 unext[4]; float glnext = 0.f;
        { const int np = hasn ? n + 1 : n;
          SCAN_COPY(chunk0 + (size_t)np * IMG_BYTES, cur ^ 1); SCAN_LOAD(np, unext, zr0, zr1, glnext); }
        bf16_t ov[16];
        bf16x8 Sb[4];
#pragma unroll
        for (int s = 0; s < 4; ++s) Sb[s] = acc2frag(Sacc[2 * s], Sacc[2 * s + 1]);
        f32x4 vn[4], o[4];
        bf16x8 wf[2][4], qf[2][4];
#pragma unroll
        for (int s = 0; s < 4; ++s) { wf[0][s] = ldfrag(img + IMG_WD + fr * SWD + 32 * s + 4 * fq); qf[0][s] = ldfrag(img + IMG_QD + fr * SWD + 32 * s + 4 * fq); }
#pragma unroll
        for (int mm = 0; mm < 4; ++mm) {
            if (mm < 3) {
#pragma unroll
                for (int s = 0; s < 4; ++s) { wf[(mm + 1) & 1][s] = ldfrag(img + IMG_WD + (16 * (mm + 1) + fr) * SWD + 32 * s + 4 * fq); qf[(mm + 1) & 1][s] = ldfrag(img + IMG_QD + (16 * (mm + 1) + fr) * SWD + 32 * s + 4 * fq); } }
            f32x4 c = (f32x4){0.f, 0.f, 0.f, 0.f}, d = (f32x4){0.f, 0.f, 0.f, 0.f};
#pragma unroll
            for (int s = 0; s < 4; ++s) {
                c = __builtin_amdgcn_mfma_f32_16x16x32_bf16(wf[mm & 1][s], Sb[s], c, 0, 0, 0);
                d = __builtin_amdgcn_mfma_f32_16x16x32_bf16(qf[mm & 1][s], Sb[s], d, 0, 0, 0);
            }
            vn[mm] = ucur[mm] - c; o[mm] = d;
        }
        bf16x8 kq[4][2], kt[4][2];
#pragma unroll
        for (int mm = 0; mm < 4; ++mm)
#pragma unroll
            for (int s = 0; s < 2; ++s) kq[mm][s] = ldfrag(img + IMG_QK + (16 * mm + fr) * SKT + 32 * s + 4 * fq);
#pragma unroll
        for (int m = 0; m < 4; ++m)
#pragma unroll
            for (int s = 0; s < 2; ++s) kt[m][s] = ldfrag(img + IMG_KT + (16 * m + fr) * SKT + 32 * s + 4 * fq);
        bf16x8 vb[2];
#pragma unroll
        for (int s = 0; s < 2; ++s) vb[s] = acc2frag(vn[2 * s], vn[2 * s + 1]);
#pragma unroll
        for (int mm = 0; mm < 4; ++mm)
#pragma unroll
            for (int s = 0; s < 2; ++s) o[mm] = __builtin_amdgcn_mfma_f32_16x16x32_bf16(kq[mm][s], vb[s], o[mm], 0, 0, 0);
#pragma unroll
        for (int m = 0; m < 4; ++m)
#pragma unroll
            for (int s = 0; s < 2; ++s) kq[m][s] = ldfrag(img + IMG_KT + (16 * (m + 4) + fr) * SKT + 32 * s + 4 * fq);
#pragma unroll
        for (int m = 0; m < 4; ++m) {
            f32x4 c = Sacc[m] * glcur;
#pragma unroll
            for (int s = 0; s < 2; ++s) c = __builtin_amdgcn_mfma_f32_16x16x32_bf16(kt[m][s], vb[s], c, 0, 0, 0);
            Sacc[m] = c;
        }
#pragma unroll
        for (int m = 0; m < 4; ++m) {
            f32x4 c = Sacc[m + 4] * glcur;
#pragma unroll
            for (int s = 0; s < 2; ++s) c = __builtin_amdgcn_mfma_f32_16x16x32_bf16(kq[m][s], vb[s], c, 0, 0, 0);
            Sacc[m + 4] = c;
        }
#pragma unroll
        for (int mm = 0; mm < 4; ++mm)
#pragma unroll
            for (int rg = 0; rg < 4; ++rg) { const float sr = dpp_sum16(o[mm][rg] * o[mm][rg]);
                if (fr == 0) SCR[(16 * mm + 4 * fq + rg) * 8 + wave] = sr; }
        BAR_LDS();
        { LAS float* RS = SCR + 512 + wave * 64;
          const f32x4 p0 = *(const LAS f32x4*)(SCR + lane * 8), p1 = *(const LAS f32x4*)(SCR + lane * 8 + 4);
          const float ssq = ((p0.x + p0.y) + (p0.z + p0.w)) + ((p1.x + p1.y) + (p1.z + p1.w));
          RS[lane] = rsqrtf(ssq * (1.f / 128.f) + EPS);
          asm volatile("s_waitcnt lgkmcnt(0)" ::: "memory");
#pragma unroll
          for (int mm = 0; mm < 4; ++mm) { const f32x4 rs = *(const LAS f32x4*)(RS + 16 * mm + 4 * fq);
#pragma unroll
              for (int rg = 0; rg < 4; ++rg) ov[mm * 4 + rg] = f2bf(o[mm][rg] * rs[rg] * gnorm * siluf_(bf2f(ZT[(16 * mm + 4 * fq + rg) * 136 + e0 + fr]))); } }
        asm volatile("s_waitcnt vmcnt(0)" ::: "memory");
        { bf16_t* gp = GDN + ((size_t)b * SEQ + n * 64) * DM + h * 128 + e0 + fr;
#pragma unroll
          for (int mm = 0; mm < 4; ++mm)
#pragma unroll
              for (int rg = 0; rg < 4; ++rg) gp[(size_t)(16 * mm + 4 * fq + rg) * DM] = ov[mm * 4 + rg]; }
        BAR_LDS();
        *(LAS u32x4*)ztw = zr0; *(LAS u32x4*)(ztw + 8) = zr1;
#pragma unroll
        for (int mm = 0; mm < 4; ++mm) ucur[mm] = unext[mm];
        glcur = glnext;
    }
#undef SCAN_COPY
#undef SCAN_LOAD
    float* so = p.out + O_SSMP + (size_t)bh * 16384;
#pragma unroll
    for (int m = 0; m < 8; ++m)
#pragma unroll
        for (int rg = 0; rg < 4; ++rg) so[(16 * m + 4 * fq + rg) * 128 + e0 + fr] = Sacc[m][rg];
    __syncthreads();
}

struct SamplePre { float sraw[32]; float cw[4]; float sc[3]; bf16_t pj; float g, be; bf16_t z; };
__device__ __forceinline__ void sample_load(const Params& p, int su, int tid, SamplePre& P) {
    const int s = su >> 4, h = su & 15, e = tid & 127, dg = tid >> 7; const size_t prow = (size_t)(MP + s);
    const bf16_t* PROJ = (const bf16_t*)(p.ws + WS_PROJ); const float* GB = (const float*)(p.ws + WS_GB);
    const float* S0 = p.in[6] + (size_t)su * 16384 + (size_t)(dg * 32) * 128 + e;
#pragma unroll
    for (int i = 0; i < 32; ++i) P.sraw[i] = __builtin_nontemporal_load(&S0[i * 128]);
    { const int ch = tid < 384 ? tid : 0; const int which = ch >> 7, dd = ch & 127, col = which * 2048 + h * 128 + dd;
      const float* cw = p.in[11] + col; const float* sc = p.in[5] + (size_t)s * 3 * 6144 + col;
      P.cw[0] = cw[0]; P.cw[1] = cw[6144]; P.cw[2] = cw[2 * 6144]; P.cw[3] = cw[3 * 6144];
      P.sc[0] = sc[0]; P.sc[1] = sc[6144]; P.sc[2] = sc[2 * 6144]; P.pj = PROJ[prow * NQ + 1024 + col]; }
    P.g = GB[prow * 32 + h]; P.be = GB[prow * 32 + 16 + h];
    P.z = PROJ[prow * NQ + 7168 + h * 128 + e];
}
__device__ __forceinline__ void phase_sample(const Params& p, LAS unsigned char* lds, int c, int G, int wave_s) {
    const int tid = opaque_tid(wave_s), lane = tid & 63, wave = tid >> 6;
    bf16_t* GDN = (bf16_t*)(p.ws + WS_GDNOUT);
    LAS float* vals = (LAS float*)lds;
    LAS float* part = vals + 384;
    LAS float* red = part + 8;
    LAS float* red2 = red + 512;
    LAS float* part2 = red2 + 512;
    const int e = tid & 127, dg = tid >> 7;
    const float gn = p.in[14][e];
    SamplePre cur, nx;
    if (c < 2048) sample_load(p, c, tid, cur);
    for (int su = c; su < 2048; su += G) {
        const int s = su >> 4, h = su & 15; const size_t prow = (size_t)(MP + s);
        const bool hasn = (su + G < 2048);
        if (hasn) sample_load(p, su + G, tid, nx);
        float y = 0.f;
        if (tid < 384) { y = cur.cw[0] * cur.sc[0] + cur.cw[1] * cur.sc[1] + cur.cw[2] * cur.sc[2] + cur.cw[3] * bf2f(cur.pj); y = siluf_(y); vals[tid] = y; }
        { const float ss = wave_sum(y * y); if (lane == 0) part[wave] = ss; }
        BAR_LDS();
        const float rq = rsqrtf(part[0] + part[1] + EPS) * 0.08838834764831845f, rk = rsqrtf(part[2] + part[3] + EPS);
        const float eg = __expf(cur.g), be = cur.be;
        float Sd[32]; float ks = 0.f;
#pragma unroll
        for (int i = 0; i < 32; ++i) Sd[i] = cur.sraw[i] * eg;
#pragma unroll
        for (int i = 0; i < 32; ++i) ks += vals[128 + dg * 32 + i] * rk * Sd[i];
        red[dg * 128 + e] = ks;
        BAR_LDS();
        const float kS = (red[e] + red[128 + e]) + (red[256 + e] + red[384 + e]);
        const float vnew = be * (vals[256 + e] - kS);
        float* So = p.out + O_SSMS + (size_t)su * 16384 + (size_t)(dg * 32) * 128 + e;
        float os = 0.f;
#pragma unroll
        for (int i = 0; i < 32; ++i) { const float sn = Sd[i] + vals[128 + dg * 32 + i] * rk * vnew; __builtin_nontemporal_store(sn, &So[i * 128]); os += vals[dg * 32 + i] * rq * sn; }
        red2[dg * 128 + e] = os;
        BAR_LDS();
        float o = 0.f;
        if (tid < 128) { o = (red2[e] + red2[128 + e]) + (red2[256 + e] + red2[384 + e]); const float ss = wave_sum(o * o); if (lane == 0) part2[wave] = ss; }
        BAR_LDS();
        if (tid < 128) { const float rstd = rsqrtf((part2[0] + part2[1]) * (1.f / 128.f) + EPS);
            GDN[prow * DM + h * 128 + e] = f2bf(o * rstd * gn * siluf_(bf2f(cur.z))); }
        BAR_LDS();
        cur = nx;
    }
    __syncthreads();
}

__device__ __forceinline__ f32x4 mini_acc(const bf16_t* A, int lda, const bf16_t* Bt, int ldb, int K, int n0, int wave, int fr, int fq, LAS unsigned char* lds) {
    asm volatile("" : "+s"(lda), "+s"(ldb));
    const int lane = fq * 16 + fr, ks = K >> 3;
    const bf16_t* ap = A + (size_t)(MP + fr) * lda + wave * ks + 8 * fq;
    const bf16_t* bp = Bt + (size_t)(n0 + fr) * ldb + wave * ks + 8 * fq;
    f32x4 acc[8];
#pragma unroll
    for (int m = 0; m < 8; ++m) acc[m] = (f32x4){0.f, 0.f, 0.f, 0.f};
    for (int k = 0; k < ks; k += 64) {
        const bool two = (k + 32 < ks);
        bf16x8 bq[2], aq[2][8];
        bq[0] = *(const bf16x8*)(bp + k);
#pragma unroll
        for (int m = 0; m < 8; ++m) aq[0][m] = *(const bf16x8*)(ap + (size_t)(16 * m) * lda + k);
        if (two) { bq[1] = *(const bf16x8*)(bp + k + 32);
#pragma unroll
            for (int m = 0; m < 8; ++m) aq[1][m] = *(const bf16x8*)(ap + (size_t)(16 * m) * lda + k + 32); }
#pragma unroll
        for (int m = 0; m < 8; ++m) acc[m] = __builtin_amdgcn_mfma_f32_16x16x32_bf16(bq[0], aq[0][m], acc[m], 0, 0, 0);
        if (two) {
#pragma unroll
            for (int m = 0; m < 8; ++m) acc[m] = __builtin_amdgcn_mfma_f32_16x16x32_bf16(bq[1], aq[1][m], acc[m], 0, 0, 0); }
    }
    LAS f32x4* RED = (LAS f32x4*)lds;
#pragma unroll
    for (int m = 0; m < 8; ++m) RED[(wave * 8 + m) * 64 + lane] = acc[m];
    BAR_LDS();
    f32x4 r = (f32x4){0.f, 0.f, 0.f, 0.f};
#pragma unroll
    for (int w2 = 0; w2 < 8; ++w2) r += RED[(w2 * 8 + wave) * 64 + lane];
    BAR_LDS();
    return r;
}
__device__ __forceinline__ f32x4 bf4_to_f32(u32x2 w) { return (f32x4){bflo(w.x), bfhi(w.x), bflo(w.y), bfhi(w.y)}; }
__device__ __forceinline__ u32x2 f32_to_bf4(f32x4 v) { u32x2 w; w.x = pk2(v[0], v[1]); w.y = pk2(v[2], v[3]); return w; }

#define XB_XCNT(j)  (256  + 64 * (j))
#define XB_XSUB(j)  (1280 + 64 * (j))
#define XB_XGEN(j)  (2304 + 64 * (j))
#define XB_TOP      3328
#define XB_TOPGEN   3392
#define XCD_BAR_WORDS 3456
__device__ __forceinline__ unsigned xb_ld(unsigned* p)              { return __hip_atomic_load(p, __ATOMIC_RELAXED, __HIP_MEMORY_SCOPE_AGENT); }
__device__ __forceinline__ unsigned xb_add(unsigned* p, unsigned v) { return __hip_atomic_fetch_add(p, v, __ATOMIC_RELAXED, __HIP_MEMORY_SCOPE_AGENT); }
__device__ __forceinline__ unsigned xb_xcc_id() { return (unsigned)__builtin_amdgcn_s_getreg((3 << 11) | 20) & 0xFu; }
__device__ __forceinline__ void xcd_barrier(unsigned* bar, volatile LAS unsigned* st, int wave_s) {
    asm volatile("s_waitcnt vmcnt(0)" ::: "memory");
    __syncthreads();
    if (opaque_tid(wave_s) == 0) {
        __builtin_amdgcn_s_waitcnt(0);
        const unsigned x = xb_xcc_id();
        unsigned nloc = st[0], nx = st[1];
        if (nloc == 0u) {
            const unsigned G = gridDim.x; unsigned sum, cnt, mine;
            for (;;) { sum = 0u; cnt = 0u; mine = 0u;
#pragma unroll
                for (unsigned j = 0; j < 16; ++j) { const unsigned c = xb_ld(&bar[XB_XCNT(j)]); sum += c; cnt += (c > 0u) ? 1u : 0u; mine = (j == x) ? c : mine; }
                if (sum == G) break;
                __builtin_amdgcn_s_sleep(1); }
            nloc = mine > 0u ? mine : 1u; nx = cnt > 0u ? cnt : 1u; st[0] = nloc; st[1] = nx; }
        const unsigned old = xb_add(&bar[XB_XSUB(x)], 1u);
        const unsigned gen = old / nloc;
        if (old + 1u == (gen + 1u) * nloc) {
            __builtin_amdgcn_fence(__ATOMIC_RELEASE, "agent");
            asm volatile("s_waitcnt vmcnt(0)" ::: "memory");
            const unsigned og = xb_add(&bar[XB_TOP], 1u);
            const unsigned tg = og / nx;
            if (og + 1u == (tg + 1u) * nx) xb_add(&bar[XB_TOPGEN], 1u);
            else { while (xb_ld(&bar[XB_TOPGEN]) == tg) __builtin_amdgcn_s_sleep(1); }
            __builtin_amdgcn_fence(__ATOMIC_ACQUIRE, "agent");
            xb_add(&bar[XB_XGEN(x)], 1u);
            asm volatile("s_waitcnt vmcnt(0)" ::: "memory");
        } else {
            while (xb_ld(&bar[XB_XGEN(x)]) == gen) __builtin_amdgcn_s_sleep(1);
            __builtin_amdgcn_fence(__ATOMIC_ACQUIRE, "agent");
            asm volatile("s_waitcnt vmcnt(0)" ::: "memory");
        }
    }
    __syncthreads();
}
__global__ void __launch_bounds__(512, 2) mega(Params p) {
    extern __shared__ __attribute__((aligned(16))) unsigned char lds_raw[];
    LAS unsigned char* lds = (LAS unsigned char*)lds_raw;
    unsigned* bar = (unsigned*)(p.ws + WS_BAR);
    volatile LAS unsigned* bst = (volatile LAS unsigned*)(lds + LDS_BYTES - 16);
    if (p.ph_lo < 0) { cg::this_grid().sync(); }
    const int lo = p.ph_lo, hi = p.ph_hi;
    const int G = gridDim.x, bx = blockIdx.x;
    const int wave_s = __builtin_amdgcn_readfirstlane(threadIdx.x >> 6);
    if (threadIdx.x == 0) { bst[0] = 0u; bst[1] = 0u; (void)xb_add(&bar[XB_XCNT(xb_xcc_id())], 1u); }
    __syncthreads();
    unsigned char* ws = p.ws;
#define IN(k) (lo <= (k) && (k) < hi)
#define SEAM(k) do { if (IN(k) && IN((k) + 1)) xcd_barrier(bar, bst, wave_s); } while (0)

    if (IN(0)) { phase0(p, lds, wave_s); }
    SEAM(0);
    if (IN(1)) {
        pg8::Gemm g{(const bf16_t*)(ws + WS_H), (const bf16_t*)(ws + WS_WIN), DM, DM, DM, 33, 53, 0};
        pg8::StaticOrder S; S.init(33, 53, G, bx);
        EpiProj E{(bf16_t*)(ws + WS_PROJ), (bf16_t*)(ws + WS_GATES), (float*)(ws + WS_GB), p.in[12], p.in[13], p.out};
        pg8::gemm_phase(lds, g, S, E, wave_s);
    }
    SEAM(1);
    if (IN(2)) { phase_pool_d(p, wave_s); phase_chunk_prep(p, lds, wave_s); }
    SEAM(2);
    if (IN(3)) {
        if (bx < 64) phase_scan(p, lds, bx, wave_s);
        else {
            phase_sample(p, lds, bx - 64, G - 64, wave_s);
            pg8::Gemm g{(const bf16_t*)(ws + WS_D), (const bf16_t*)(ws + WS_WPOOL), 1024, 256, 256, 33, 4, 256};
            pg8::StaticOrder S; S.init(33, 4, G - 64, bx - 64);
            EpiPoolGrp E{(bf16_t*)(ws + WS_POOLOUT), p.in[10]};
            pg8::gemm_phase(lds, g, S, E, wave_s);
            { const int tid = opaque_tid(wave_s), lane = tid & 63, wave = tid >> 6;
              convert_items(p, (LAS float*)(lds + wave * 8448), lane, (bx - 64) * 8 + wave, (G - 64) * 8, CV_SPLIT, CV_END); }
        }
    }
    SEAM(3);
    if (IN(4)) {
        { pg8::Gemm g{(const bf16_t*)(ws + WS_POOLOUT), (const bf16_t*)(ws + WS_WPU), 1024, 1024, 1024, 32, 8, 0};
          pg8::StaticOrder S; S.init(32, 8, G, bx);
          EpiPoolUp E{(bf16_t*)(ws + WS_T1), (const bf16_t*)(ws + WS_GATES)};
          pg8::gemm_phase(lds, g, S, E, wave_s); }
        { pg8::Gemm g{(const bf16_t*)(ws + WS_GDNOUT), (const bf16_t*)(ws + WS_WGU), DM, DM, DM, 32, 8, 0};
          pg8::StaticOrder S; S.init(32, 8, G, bx);
          EpiMerge E{(const bf16_t*)(ws + WS_T1), (const bf16_t*)(ws + WS_GATES), (bf16_t*)(ws + WS_MERGED)};
          pg8::gemm_phase(lds, g, S, E, wave_s); }
        {
            const int tid = opaque_tid(wave_s), lane = tid & 63, wave = tid >> 6, fr = lane & 15, fq = lane >> 4;
            for (int nt = bx; nt < 128; nt += G) { const int n0 = nt * 16; const f32x4 z4 = (f32x4){0.f, 0.f, 0.f, 0.f};
                const f32x4 a1 = mini_acc((const bf16_t*)(ws + WS_POOLOUT), 1024, (const bf16_t*)(ws + WS_WPU), 1024, 1024, n0, wave, fr, fq, lds);
                const f32x4 a2 = mini_acc((const bf16_t*)(ws + WS_GDNOUT), DM, (const bf16_t*)(ws + WS_WGU), DM, DM, n0, wave, fr, fq, lds);
                const size_t r = MP + 16 * wave + fr; const int c = n0 + 4 * fq;
                const f32x4 gp = bf4_to_f32(*(const u32x2*)((const bf16_t*)(ws + WS_GATES) + r * NG + c)), gg = bf4_to_f32(*(const u32x2*)((const bf16_t*)(ws + WS_GATES) + r * NG + 2048 + c));
                *(u32x2*)((bf16_t*)(ws + WS_MERGED) + r * DM + c) = f32_to_bf4(gp * a1 + gg * a2); }
        }
    }
    SEAM(4);
    if (IN(5)) {
        { pg8::Gemm g{(const bf16_t*)(ws + WS_MERGED), (const bf16_t*)(ws + WS_WO), DM, DM, DM, 32, 8, 0};
          pg8::StaticOrder S; S.init(32, 8, G, bx);
          EpiWo E{p.in[0], p.in[1], (bf16_t*)(ws + WS_X1)};
          pg8::gemm_phase(lds, g, S, E, wave_s); }
        {
            const int tid = opaque_tid(wave_s), lane = tid & 63, wave = tid >> 6, fr = lane & 15, fq = lane >> 4;
            for (int nt = bx; nt < 128; nt += G) { const int n0 = nt * 16;
                const f32x4 a1 = mini_acc((const bf16_t*)(ws + WS_MERGED), DM, (const bf16_t*)(ws + WS_WO), DM, DM, n0, wave, fr, fq, lds);
                const size_t r = MP + 16 * wave + fr; const int c = n0 + 4 * fq;
                *(u32x2*)((bf16_t*)(ws + WS_X1) + r * DM + c) = f32_to_bf4(*(const f32x4*)(p.in[1] + (r - MP) * DM + c) + a1); }
        }
    }
    SEAM(5);
    if (IN(6)) {
        const int tid = opaque_tid(wave_s), lane = tid & 63, wave = tid >> 6;
        const int gw = bx * 8 + wave, NGW = G * 8;
        for (int m = gw; m < MT; m += NGW) rms_row_b2b((const bf16_t*)(ws + WS_X1) + (size_t)m * DM, p.in[18], (bf16_t*)(ws + WS_H2) + (size_t)m * DM, lane);
    }
    SEAM(6);
    if (IN(7)) {
        pg8::Gemm g{(const bf16_t*)(ws + WS_H2), (const bf16_t*)(ws + WS_WGATE), DM, DM, DM, 33, 44, 0};
        pg8::StaticOrder S; S.init(33, 44, G, bx);
        EpiGateUp E{(bf16_t*)(ws + WS_ACT)};
        pg8::gemm_phase(lds, g, S, E, wave_s);
    }
    SEAM(7);
    if (IN(8)) {
        { pg8::Gemm g{(const bf16_t*)(ws + WS_ACT), (const bf16_t*)(ws + WS_WDOWN), DFF, DFF, DFF, 32, 8, 0};
          pg8::StaticOrder S; S.init(32, 8, G, bx);
          EpiDown E{(const bf16_t*)(ws + WS_X1), (bf16_t*)(ws + WS_X2B)};
          pg8::gemm_phase(lds, g, S, E, wave_s); }
        {
            const int tid = opaque_tid(wave_s), lane = tid & 63, wave = tid >> 6, fr = lane & 15, fq = lane >> 4;
            for (int nt = bx; nt < 128; nt += G) { const int n0 = nt * 16;
                const f32x4 a1 = mini_acc((const bf16_t*)(ws + WS_ACT), DFF, (const bf16_t*)(ws + WS_WDOWN), DFF, DFF, n0, wave, fr, fq, lds);
                const size_t r = MP + 16 * wave + fr; const int c = n0 + 4 * fq;
                const f32x4 x2 = bf4_to_f32(*(const u32x2*)((const bf16_t*)(ws + WS_X1) + r * DM + c)) + a1;
                *(u32x2*)((bf16_t*)(ws + WS_X2B) + r * DM + c) = f32_to_bf4(x2); }
        }
    }
    SEAM(8);
    if (IN(9)) {
        { pg8::Gemm g{(const bf16_t*)(ws + WS_PBF), (const bf16_t*)(ws + WS_WPLE), 256, 256, 256, 32, 8, 0};
          pg8::StaticOrder S; S.init(32, 8, G, bx);
          EpiPle E{(bf16_t*)(ws + WS_T2)};
          pg8::gemm_phase(lds, g, S, E, wave_s); }
        { pg8::Gemm g{(const bf16_t*)(ws + WS_X2B), (const bf16_t*)(ws + WS_WPLEG), DM, DM, DM, 32, 8, 0};
          pg8::StaticOrder S; S.init(32, 8, G, bx);
          EpiPleGate E{(bf16_t*)(ws + WS_X1), (const bf16_t*)(ws + WS_X2B), (const bf16_t*)(ws + WS_T2)};
          pg8::gemm_phase(lds, g, S, E, wave_s); }
        {
            const int tid = opaque_tid(wave_s), lane = tid & 63, wave = tid >> 6, fr = lane & 15, fq = lane >> 4;
            for (int nt = bx; nt < 128; nt += G) { const int n0 = nt * 16; const f32x4 z4 = (f32x4){0.f, 0.f, 0.f, 0.f};
                const f32x4 a1 = mini_acc((const bf16_t*)(ws + WS_PBF), 256, (const bf16_t*)(ws + WS_WPLE), 256, 256, n0, wave, fr, fq, lds);
                const f32x4 a2 = mini_acc((const bf16_t*)(ws + WS_X2B), DM, (const bf16_t*)(ws + WS_WPLEG), DM, DM, n0, wave, fr, fq, lds);
                const size_t r = MP + 16 * wave + fr; const int c = n0 + 4 * fq;
                f32x4 x3 = bf4_to_f32(*(const u32x2*)((const bf16_t*)(ws + WS_X2B) + r * DM + c));
#pragma unroll
                for (int j = 0; j < 4; ++j) x3[j] += a1[j] * sigmoidf_(a2[j]);
                *(u32x2*)((bf16_t*)(ws + WS_X1) + r * DM + c) = f32_to_bf4(x3); }
        }
    }
    SEAM(9);
    if (IN(10)) {
        const int tid = opaque_tid(wave_s), lane = tid & 63, wave = tid >> 6;
        const int gw = bx * 8 + wave, NGW = G * 8;
        for (int m = gw; m < MR; m += NGW) {
            float* dst = (m < MP) ? p.out + O_YP + (size_t)m * DM : p.out + O_YS + (size_t)(m - MP) * DM;
            rms_row_b2f((const bf16_t*)(ws + WS_X1) + (size_t)m * DM, p.in[23], dst, lane);
        }
    }
#undef IN
#undef SEAM
}

extern "C" void kernel_launch(void* const* d_in, const int* in_sizes, int n_in, void* d_out, int out_size, void* d_ws, size_t ws_size, hipStream_t stream) {
    static int grid = 0;
    if (grid == 0) {
        if (n_in != 24 || ws_size < WS_END) { fprintf(stderr, "kernel_launch: need 24 inputs and %zu bytes of workspace (got %d, %zu)\n", (size_t)WS_END, n_in, ws_size); grid = -1; return; }
        int dev = 0, cus = 0, per_cu = 0;
        hipGetDevice(&dev); hipDeviceGetAttribute(&cus, hipDeviceAttributeMultiprocessorCount, dev);
        if (hipFuncSetAttribute((const void*)mega, hipFuncAttributeMaxDynamicSharedMemorySize, LDS_BYTES) != hipSuccess) { fprintf(stderr, "kernel_launch: hipFuncSetAttribute failed\n"); grid = -1; return; }
        hipOccupancyMaxActiveBlocksPerMultiprocessor(&per_cu, (const void*)mega, 512, LDS_BYTES);
        (void)hipGetLastError();
        if (per_cu < 1) per_cu = 1;
        grid = cus * per_cu;
        if (grid < 128) grid = 128;
    }
    if (grid < 0) return;
    if (hipMemsetAsync((char*)d_ws + WS_BAR, 0, 16384, stream) != hipSuccess) { fprintf(stderr, "memset failed\n"); return; }
    Params p{};
    for (int i = 0; i < 24; ++i) p.in[i] = (const float*)d_in[i];
    p.out = (float*)d_out; p.ws = (unsigned char*)d_ws; p.ph_lo = 0; p.ph_hi = 11;
    void* args[] = {&p};
    hipError_t e = hipLaunchCooperativeKernel((const void*)mega, dim3(grid), dim3(512), args, LDS_BYTES, stream);
    if (e != hipSuccess) fprintf(stderr, "cooperative launch failed: %s (grid %d)\n", hipGetErrorString(e), grid);
}
```
